# Optimizing an MI355X kernel written in HIP

```python
import jax
import jax.numpy as jnp
from jax import lax
import numpy as np


D_MODEL = 1024
BATCH = 32
SEQ = 2048
DEPTH = 2

CTX_LEN = 256
GRID_W = 64
N_MIXERS = 2
ADA_CHUNKS = 6
NORM_EPS = 1e-6

HG_HEADS = 8
HG_DK = D_MODEL // HG_HEADS
HG_DV = D_MODEL // HG_HEADS
HG_CHUNK = 32

MLA_HEADS = 16
MLA_Q_LORA = 256
MLA_KV_LORA = 128
MLA_NOPE = 64
MLA_ROPE = 32
MLA_V = 64
MLA_QK = MLA_NOPE + MLA_ROPE
ROPE_THETA = 10000.0
Q_BLOCK = 128

MOE_GROUPS = 4
MOE_EXPERTS_PER_GROUP = 8
MOE_EXPERTS = MOE_GROUPS * MOE_EXPERTS_PER_GROUP
MOE_TOP_K = 2
MOE_FF = 512
MOE_BLOCK = 256

kernel_name = 'hybrid_hgrn2_mla_hmoe_dit'


def rms_norm(x, g):
    xf = x.astype(jnp.float32)
    y = xf * lax.rsqrt(jnp.mean(xf * xf, axis=-1, keepdims=True) + NORM_EPS)
    return (y * g.astype(jnp.float32)).astype(x.dtype)


def modulate(x, g, shift, scale):
    return rms_norm(x, g) * (1 + scale) + shift


def gla_chunkwise(q, k, v, log_f, s0):
    b_, h_, L, _ = q.shape
    n_chunks = L // HG_CHUNK

    def chunks(a):
        return jnp.moveaxis(a.reshape(b_, h_, n_chunks, HG_CHUNK, a.shape[-1]), 2, 0)

    lower_tri = jnp.tril(jnp.ones((HG_CHUNK, HG_CHUNK), dtype=bool))

    def step(s, blk):
        qc, kc, vc, gc = blk
        b = jnp.cumsum(gc, axis=-2)
        b_end = b[:, :, -1:, :]
        q_dec = qc * jnp.exp(b)
        scores = jnp.einsum('bhtc,bhsc->bhts', q_dec, kc * jnp.exp(-b))
        scores = jnp.where(lower_tri, scores, 0.0)
        o = jnp.einsum('bhts,bhsv->bhtv', scores, vc) + jnp.einsum('bhtc,bhcv->bhtv', q_dec, s)
        s_new = jnp.exp(b_end[:, :, 0, :])[..., None] * s + jnp.einsum('bhsc,bhsv->bhcv', kc * jnp.exp(b_end - b), vc)
        return s_new, o

    s_fin, o = lax.scan(step, s0, (chunks(q), chunks(k), chunks(v), chunks(log_f)))
    return jnp.moveaxis(o, 0, 2).reshape(b_, h_, L, v.shape[-1]), s_fin


def hgrn2_mixer(h_lat, h_ctx, w_in, lower_bound, out_norm_g, w_out, with_ctx_out):
    lb = lower_bound.astype(jnp.float32).reshape(2, HG_HEADS, 1, HG_DK)

    def prepare(h):
        b_, L, _ = h.shape
        p = jnp.einsum('bld,de->ble', h, w_in)
        q, z_fw, z_bw, v, g = jnp.split(p, 5, axis=-1)

        def heads(a):
            return a.reshape(b_, L, HG_HEADS, -1).transpose(0, 2, 1, 3).astype(jnp.float32)

        f_fw = lb[0] + (1 - lb[0]) * jax.nn.sigmoid(heads(z_fw))
        f_bw = lb[1] + (1 - lb[1]) * jax.nn.sigmoid(heads(z_bw))
        return jax.nn.silu(heads(q)), heads(v), (1 - f_fw, jnp.log(f_fw)), (1 - f_bw, jnp.log(f_bw)), g

    def flip(a):
        return jnp.flip(a, axis=2)

    def readout(o, g):
        b_, _, L, _ = o.shape
        o = rms_norm(o, out_norm_g).transpose(0, 2, 1, 3).reshape(b_, L, D_MODEL)
        return jnp.einsum('ble,ed->bld', o.astype(g.dtype) * jax.nn.silu(g), w_out)

    qc, vc, (kc_f, gc_f), (kc_b, gc_b), g_c = prepare(h_ctx)
    s0 = jnp.zeros(qc.shape[:2] + (HG_DK, HG_DV), jnp.float32)
    o_c_f, s_f = gla_chunkwise(qc, kc_f, vc, gc_f, s0)
    o_c_b, s_b = gla_chunkwise(flip(qc), flip(kc_b), flip(vc), flip(gc_b), s0)
    ql, vl, (kl_f, gl_f), (kl_b, gl_b), g_l = prepare(h_lat)
    o_l_f, _ = gla_chunkwise(ql, kl_f, vl, gl_f, s_f)
    o_l_b, _ = gla_chunkwise(flip(ql), flip(kl_b), flip(vl), flip(gl_b), s_b)
    y_lat = readout(o_l_f + flip(o_l_b), g_l)
    y_ctx = readout(o_c_f + flip(o_c_b), g_c) if with_ctx_out else None
    return y_lat, y_ctx


def axial_rope_tables(L):
    rows = L // GRID_W
    row = jnp.repeat(jnp.arange(rows), GRID_W)
    col = jnp.tile(jnp.arange(GRID_W), rows)
    half = MLA_ROPE // 2
    inv_freq = ROPE_THETA ** (-jnp.arange(0, half, 2, dtype=jnp.float32) / half)
    ang = jnp.stack([row, col], axis=-1).astype(jnp.float32)[..., None] * inv_freq
    ang = jnp.concatenate([ang, ang], axis=-1)
    return jnp.cos(ang), jnp.sin(ang)


def apply_axial_rope(x, cos, sin):
    b_, L, h_, _ = x.shape
    x_nope = x[..., :MLA_NOPE]
    x_rope = x[..., MLA_NOPE:].reshape(b_, L, h_, 2, MLA_ROPE // 2)
    x1, x2 = jnp.split(x_rope, 2, axis=-1)
    rot = jnp.concatenate([-x2, x1], axis=-1)
    cos = cos[:, None].astype(x.dtype)
    sin = sin[:, None].astype(x.dtype)
    x_rope = (x_rope * cos + rot * sin).reshape(b_, L, h_, MLA_ROPE)
    return jnp.concatenate([x_nope, x_rope], axis=-1)


def mla_queries(c_q, q_norm_g, w_qb, q_qk_g):
    b_, L, _ = c_q.shape
    q = jnp.einsum('blr,re->ble', rms_norm(c_q, q_norm_g), w_qb).reshape(b_, L, MLA_HEADS, MLA_QK)
    return rms_norm(q, q_qk_g)


def mla_keys_values(c_kv, k_rope, kv_norm_g, w_kvb, k_qk_g):
    b_, L, _ = c_kv.shape
    kv = jnp.einsum('blr,re->ble', rms_norm(c_kv, kv_norm_g), w_kvb).reshape(b_, L, MLA_HEADS, MLA_NOPE + MLA_V)
    k_nope, v = jnp.split(kv, [MLA_NOPE], axis=-1)
    k = jnp.concatenate([k_nope, jnp.broadcast_to(k_rope[:, :, None, :], (b_, L, MLA_HEADS, MLA_ROPE))], axis=-1)
    return rms_norm(k, k_qk_g), v


def softmax_attend(q, k, v):
    s = jnp.einsum('bqhd,bkhd->bhqk', q, k).astype(jnp.float32) * (MLA_QK ** -0.5)
    p = jax.nn.softmax(s, axis=-1).astype(v.dtype)
    return jnp.einsum('bhqk,bkhd->bqhd', p, v)


def mla_mixer(h_lat, h_ctx, w_in, q_norm_g, kv_norm_g, w_qb, w_kvb, q_qk_g, k_qk_g, w_out, with_ctx_out):
    b_, L, _ = h_lat.shape
    ctx_len = h_ctx.shape[1]
    cos, sin = axial_rope_tables(L)
    c_q, c_kv, k_rope = jnp.split(jnp.einsum('bld,de->ble', h_lat, w_in), [MLA_Q_LORA, MLA_Q_LORA + MLA_KV_LORA], axis=-1)
    q_lat = apply_axial_rope(mla_queries(c_q, q_norm_g, w_qb, q_qk_g), cos, sin)
    k_lat, v_lat = mla_keys_values(c_kv, k_rope, kv_norm_g, w_kvb, k_qk_g)
    k_lat = apply_axial_rope(k_lat, cos, sin)
    c_kv_c, k_rope_c = jnp.split(jnp.einsum('bld,de->ble', h_ctx, w_in[:, MLA_Q_LORA:]), [MLA_KV_LORA], axis=-1)
    k_ctx, v_ctx = mla_keys_values(c_kv_c, k_rope_c, kv_norm_g, w_kvb, k_qk_g)
    k_all = jnp.concatenate([k_ctx, k_lat], axis=1)
    v_all = jnp.concatenate([v_ctx, v_lat], axis=1)
    n_blk = L // Q_BLOCK
    q_blocks = q_lat.reshape(b_, n_blk, Q_BLOCK, MLA_HEADS, MLA_QK).transpose(1, 0, 2, 3, 4)
    o_lat = lax.map(lambda qb: softmax_attend(qb, k_all, v_all), q_blocks)
    o_lat = o_lat.transpose(1, 0, 2, 3, 4).reshape(b_, L, MLA_HEADS * MLA_V)
    y_lat = jnp.einsum('ble,ed->bld', o_lat, w_out)
    y_ctx = None
    if with_ctx_out:
        q_ctx = mla_queries(jnp.einsum('bld,de->ble', h_ctx, w_in[:, :MLA_Q_LORA]), q_norm_g, w_qb, q_qk_g)
        o_ctx = softmax_attend(q_ctx, k_ctx, v_ctx).reshape(b_, ctx_len, MLA_HEADS * MLA_V)
        y_ctx = jnp.einsum('ble,ed->bld', o_ctx, w_out)
    return y_lat, y_ctx


def hier_moe(h, w_group, w_expert, w_gate, w_up, w_down):
    n_tok, d = h.shape
    hf = h.astype(jnp.float32)
    g_prob = jax.nn.softmax(hf @ w_group.astype(jnp.float32), axis=-1)
    g_sel = jnp.argmax(g_prob, axis=-1)
    p_group = jnp.take_along_axis(g_prob, g_sel[:, None], axis=-1)
    e_logits = (hf @ w_expert.astype(jnp.float32)).reshape(n_tok, MOE_GROUPS, MOE_EXPERTS_PER_GROUP)
    e_logits = jnp.take_along_axis(e_logits, g_sel[:, None, None], axis=1)[:, 0]
    top_p, top_i = lax.top_k(jax.nn.softmax(e_logits, axis=-1), MOE_TOP_K)
    gate_w = p_group * top_p / jnp.sum(top_p, axis=-1, keepdims=True)
    expert_id = (g_sel[:, None] * MOE_EXPERTS_PER_GROUP + top_i).astype(jnp.int32)

    n_slot = n_tok * MOE_TOP_K
    e_flat = expert_id.reshape(n_slot)
    order = jnp.argsort(e_flat)
    e_sorted = e_flat[order]
    tok_sorted = order // MOE_TOP_K
    counts = jnp.zeros((MOE_EXPERTS,), jnp.int32).at[e_flat].add(1)
    starts = jnp.cumsum(counts) - counts
    padded = (counts + MOE_BLOCK - 1) // MOE_BLOCK * MOE_BLOCK
    pad_ends = jnp.cumsum(padded)
    pad_starts = pad_ends - padded
    dest = pad_starts[e_sorted] + jnp.arange(n_slot, dtype=jnp.int32) - starts[e_sorted]
    n_blocks = (n_slot + MOE_BLOCK - 1) // MOE_BLOCK + MOE_EXPERTS
    buf = jnp.zeros((n_blocks * MOE_BLOCK, d), h.dtype).at[dest].set(h[tok_sorted])
    block_start = jnp.arange(n_blocks, dtype=jnp.int32) * MOE_BLOCK
    block_expert = jnp.minimum(jnp.searchsorted(pad_ends, block_start, side='right'), MOE_EXPERTS - 1)

    def expert_block(args):
        xb, e = args
        return (jax.nn.silu(xb @ w_gate[e]) * (xb @ w_up[e])) @ w_down[e]

    y_buf = lax.map(expert_block, (buf.reshape(n_blocks, MOE_BLOCK, d), block_expert)).reshape(n_blocks * MOE_BLOCK, d)
    y_slot = jnp.zeros((n_slot, d), h.dtype).at[order].set(y_buf[dest])
    return jnp.einsum('nkd,nk->nd', y_slot.reshape(n_tok, MOE_TOP_K, d), gate_w.astype(h.dtype))


def setup_inputs(seed: int = 0) -> dict:
    key = jax.random.key(seed)
    ks = jax.random.split(key, 25)
    n_hg = (DEPTH + 1) // 2
    n_mla = DEPTH // 2
    D = D_MODEL

    def nrm(k, shape, scale):
        return scale * jax.random.normal(k, shape, jnp.float32)

    return {
        'x': nrm(ks[0], (BATCH, SEQ, D), 1.0),
        'c': nrm(ks[1], (BATCH, D), 1.0),
        'ctx': nrm(ks[2], (BATCH, CTX_LEN, D), 1.0),
        'c_ctx': nrm(ks[3], (D,), 1.0),
        'ada_w': nrm(ks[4], (DEPTH, D, ADA_CHUNKS * D), 0.5 * D ** -0.5),
        'ada_b': nrm(ks[5], (DEPTH, ADA_CHUNKS * D), 0.02),
        'norm_mix_g': 1.0 + nrm(ks[6], (DEPTH, D), 0.02),
        'norm_ffn_g': 1.0 + nrm(ks[7], (DEPTH, D), 0.02),
        'hg_w_in': nrm(ks[8], (n_hg, D, 5 * D), D ** -0.5),
        'hg_lower_bounds': nrm(ks[9], (2, DEPTH + 1, D), 0.1),
        'hg_out_norm_g': 1.0 + nrm(ks[10], (n_hg, HG_DV), 0.02),
        'hg_w_out': nrm(ks[11], (n_hg, D, D), D ** -0.5),
        'mla_w_in': nrm(ks[12], (n_mla, D, MLA_Q_LORA + MLA_KV_LORA + MLA_ROPE), D ** -0.5),
        'mla_q_norm_g': 1.0 + nrm(ks[13], (n_mla, MLA_Q_LORA), 0.02),
        'mla_kv_norm_g': 1.0 + nrm(ks[14], (n_mla, MLA_KV_LORA), 0.02),
        'mla_w_qb': nrm(ks[15], (n_mla, MLA_Q_LORA, MLA_HEADS * MLA_QK), MLA_Q_LORA ** -0.5),
        'mla_w_kvb': nrm(ks[16], (n_mla, MLA_KV_LORA, MLA_HEADS * (MLA_NOPE + MLA_V)), MLA_KV_LORA ** -0.5),
        'mla_q_qknorm_g': 1.0 + nrm(ks[17], (n_mla, MLA_QK), 0.02),
        'mla_k_qknorm_g': 1.0 + nrm(ks[18], (n_mla, MLA_QK), 0.02),
        'mla_w_out': nrm(ks[19], (n_mla, MLA_HEADS * MLA_V, D), (MLA_HEADS * MLA_V) ** -0.5),
        'moe_w_group': nrm(ks[20], (DEPTH, D, MOE_GROUPS), D ** -0.5),
        'moe_w_expert': nrm(ks[21], (DEPTH, D, MOE_EXPERTS), D ** -0.5),
        'moe_w_gate': nrm(ks[22], (DEPTH, MOE_EXPERTS, D, MOE_FF), D ** -0.5),
        'moe_w_up': nrm(ks[23], (DEPTH, MOE_EXPERTS, D, MOE_FF), D ** -0.5),
        'moe_w_down': nrm(ks[24], (DEPTH, MOE_EXPERTS, MOE_FF, D), MOE_FF ** -0.5),
    }


def reference(x, c, ctx, c_ctx, ada_w, ada_b, norm_mix_g, norm_ffn_g, hg_w_in, hg_lower_bounds, hg_out_norm_g, hg_w_out, mla_w_in, mla_q_norm_g, mla_kv_norm_g, mla_w_qb, mla_w_kvb, mla_q_qknorm_g, mla_k_qknorm_g, mla_w_out, moe_w_group, moe_w_expert, moe_w_gate, moe_w_up, moe_w_down):
    b_, seq, d = x.shape
    ctx_len = ctx.shape[1]
    lower_bounds = jnp.cumsum(jax.nn.softmax(hg_lower_bounds.astype(jnp.float32), axis=1), axis=1)
    x_lat, x_ctx = x, ctx
    for i in range(DEPTH):
        last = i == DEPTH - 1
        j = i // N_MIXERS
        mod_lat = (jnp.einsum('bd,de->be', jax.nn.silu(c), ada_w[i]) + ada_b[i])[:, None, :]
        mod_ctx = jax.nn.silu(c_ctx) @ ada_w[i] + ada_b[i]
        sh_m, sc_m, gt_m, sh_f, sc_f, gt_f = jnp.split(mod_lat, ADA_CHUNKS, axis=-1)
        csh_m, csc_m, cgt_m, csh_f, csc_f, cgt_f = jnp.split(mod_ctx, ADA_CHUNKS, axis=-1)
        h_lat = modulate(x_lat, norm_mix_g[i], sh_m, sc_m)
        h_ctx = modulate(x_ctx, norm_mix_g[i], csh_m, csc_m)
        if i % N_MIXERS == 0:
            y_lat, y_ctx = hgrn2_mixer(h_lat, h_ctx, hg_w_in[j], lower_bounds[:, i], hg_out_norm_g[j], hg_w_out[j], not last)
        else:
            y_lat, y_ctx = mla_mixer(h_lat, h_ctx, mla_w_in[j], mla_q_norm_g[j], mla_kv_norm_g[j], mla_w_qb[j], mla_w_kvb[j], mla_q_qknorm_g[j], mla_k_qknorm_g[j], mla_w_out[j], not last)
        x_lat = x_lat + gt_m * y_lat
        h2_lat = modulate(x_lat, norm_ffn_g[i], sh_f, sc_f).reshape(b_ * seq, d)
        if last:
            f_lat = hier_moe(h2_lat, moe_w_group[i], moe_w_expert[i], moe_w_gate[i], moe_w_up[i], moe_w_down[i])
        else:
            x_ctx = x_ctx + cgt_m * y_ctx
            h2_ctx = modulate(x_ctx, norm_ffn_g[i], csh_f, csc_f).reshape(b_ * ctx_len, d)
            f_all = hier_moe(jnp.concatenate([h2_ctx, h2_lat], axis=0), moe_w_group[i], moe_w_expert[i], moe_w_gate[i], moe_w_up[i], moe_w_down[i])
            x_ctx = x_ctx + cgt_f * f_all[: b_ * ctx_len].reshape(b_, ctx_len, d)
            f_lat = f_all[b_ * ctx_len:]
        x_lat = x_lat + gt_f * f_lat.reshape(b_, seq, d)
    return x_lat
```

```cpp
#include <hip/hip_runtime.h>
#include <cstdio>
#include <cstdint>

#ifndef MOE_FP8
#define MOE_FP8 1
#endif
#ifndef ATT_FP8
#define ATT_FP8 2
#ifndef HG_FP8
#define HG_FP8 1
#endif
#ifndef AO_FP8
#define AO_FP8 1
#endif
#endif
#ifndef MK_N_LAUNCHES
#define MK_N_LAUNCHES 1
#endif

#define GAS __attribute__((address_space(1)))
#define LAS __attribute__((address_space(3)))
typedef unsigned short bf16;
typedef short bf16x8 __attribute__((ext_vector_type(8)));
typedef float f32x4 __attribute__((ext_vector_type(4)));
typedef float f32x16 __attribute__((ext_vector_type(16)));
typedef unsigned u32x4 __attribute__((ext_vector_type(4)));
typedef unsigned u32x2 __attribute__((ext_vector_type(2)));
typedef float f32x2_t __attribute__((ext_vector_type(2)));
typedef __bf16 bf16x2_t __attribute__((ext_vector_type(2)));

constexpr int D = 1024, NB = 32, SEQ = 2048, CTXL = 256;
constexpr int TC = NB * CTXL;
constexpr int TL = NB * SEQ;
constexpr int T = TC + TL;
constexpr int KVLEN = CTXL + SEQ;
constexpr int NH = 16, QK = 96, NOPE = 64, ROPE = 32, VD = 64;
constexpr int HGH = 8, HGD = 128;
constexpr int NEXP = 32, FF = 512;
constexpr float EPS = 1e-6f;
constexpr int MAXROWS = (2 * T / 256 + NEXP) * 256;
constexpr int NWAVES = 8, NTHR = 512;

constexpr size_t MiB = 1u << 20;
constexpr size_t WS_CTL = 0, CTL_ZERO_BYTES = 256 * 1024;
constexpr size_t WS_MOD = 1 * MiB;
constexpr size_t WS_LB = 3 * MiB;
constexpr size_t WS_ROPE = WS_LB + 16384;
constexpr size_t WS_META = WS_LB + 32768;
constexpr size_t WS_BLKE = WS_LB + 65536;
constexpr size_t WS_CNT = WS_LB + 131072;
constexpr size_t WS_RQ = 4 * MiB;
constexpr size_t WS_RKV = WS_RQ + 512 * 1024;
constexpr size_t WS_EID = 5 * MiB;
constexpr size_t WS_GW = WS_EID + 1 * MiB;
constexpr size_t WS_SLOT = WS_GW + 1 * MiB;
constexpr size_t WS_TOKROW = 8 * MiB;
constexpr size_t WS_WROW = 9 * MiB;
constexpr size_t WS_WR = 10 * MiB;
constexpr size_t WS_W1T = 11 * MiB;
constexpr size_t WS_W2T = 21 * MiB;
constexpr size_t WS_WMIN = 23 * MiB;
constexpr size_t WS_WQB = 24 * MiB;
constexpr size_t WS_WKVB = 25 * MiB;
constexpr size_t WS_W4T = 26 * MiB;
constexpr size_t WS_H = 32 * MiB;
constexpr size_t WS_BIG = 176 * MiB;
constexpr size_t WS_P = WS_BIG;
constexpr size_t WS_X1 = WS_BIG;
constexpr size_t WS_X2B = WS_BIG + 164 * MiB;
constexpr size_t WS_ACT = WS_BIG + 288 * MiB;
constexpr size_t WS_Y = WS_BIG + 440 * MiB;
constexpr size_t WS_MOEW0 = 928 * MiB;
constexpr size_t WS_WRP = 976 * MiB;
constexpr size_t WS_CB = 986 * MiB;
constexpr size_t WS_RMS = 987 * MiB;
constexpr size_t WS_END = 1024 * MiB;
constexpr size_t WS_C = WS_BIG;
constexpr size_t WS_QRAW = WS_BIG + 72 * MiB;
constexpr size_t WS_SSQ = WS_BIG + 76 * MiB;
constexpr size_t WS_SS4 = WS_BIG + 72 * MiB;
constexpr size_t WS_KVRAW = WS_BIG + 312 * MiB;
constexpr size_t WS_KF = WS_BIG + 600 * MiB;
constexpr size_t WS_VF = WS_H;
constexpr size_t WS_AO = WS_BIG + 312 * MiB;
constexpr size_t WS_MOEW1 = WS_BIG;
constexpr size_t WS_ACT1 = WS_BIG + 96 * MiB;
constexpr size_t WS_Y1 = WS_BIG + 440 * MiB;
static_assert(WS_P + (size_t)T * 5120 * 2 <= WS_MOEW0, "P");
static_assert(WS_Y + (size_t)MAXROWS * 1024 * 2 <= WS_MOEW0, "Y");
static_assert(WS_KF + (size_t)NB * NH * KVLEN * QK * 2 <= WS_END, "KF");
static_assert(WS_KVRAW + (size_t)T * 2048 * 2 <= WS_KF, "KVRAW");
static_assert(WS_QRAW + (size_t)TL * 1536 * 2 <= WS_KVRAW, "QRAW");
static_assert(WS_W4T + 2 * MiB <= WS_H, "small weights");

constexpr int CW_BAR = 4096;

constexpr int RING_BYTES = 131072;
constexpr int MISC_OFF = 155648 - 512;
constexpr int LDS_BYTES = 155648;

__device__ __forceinline__ unsigned cvtpk(float lo, float hi) { f32x2_t v = {lo, hi}; bf16x2_t b = __builtin_convertvector(v, bf16x2_t); return __builtin_bit_cast(unsigned, b); }
__device__ __forceinline__ float bflo(unsigned u) { return __builtin_bit_cast(float, u << 16); }
__device__ __forceinline__ float bfhi(unsigned u) { return __builtin_bit_cast(float, u & 0xffff0000u); }
__device__ __forceinline__ float bf2f(bf16 h) { return __builtin_bit_cast(float, ((unsigned)h) << 16); }
__device__ __forceinline__ float wave_sum(float v) {
#pragma unroll
    for (int o = 1; o < 64; o <<= 1) v += __shfl_xor(v, o);
    return v;
}
__device__ __forceinline__ float half_sum(float v) {
#pragma unroll
    for (int o = 1; o < 32; o <<= 1) v += __shfl_xor(v, o);
    return v;
}
__device__ __forceinline__ float fast_exp(float x) { return __builtin_amdgcn_exp2f(x * 1.4426950408889634f); }
__device__ __forceinline__ float fast_rcp(float x) { return __builtin_amdgcn_rcpf(x); }
__device__ __forceinline__ float silu_f(float x) { return x * fast_rcp(1.0f + fast_exp(-x)); }
__device__ __forceinline__ unsigned pk4_fp8(float a, float b, float c, float d) { unsigned w; asm volatile("" : "=v"(w)); w = __builtin_amdgcn_cvt_pk_fp8_f32(a, b, w, false); w = __builtin_amdgcn_cvt_pk_fp8_f32(c, d, w, true); return w; }
#define LDS_WAIT() asm volatile("s_waitcnt lgkmcnt(0)" ::: "memory")
#define VM_WAIT() asm volatile("s_waitcnt vmcnt(0)" ::: "memory")

#define XB_TMO      128
#define XB_XCNT(j)  (256  + 64 * (j))
#define XB_XSUB(j)  (1280 + 64 * (j))
#define XB_XGEN(j)  (2304 + 64 * (j))
#define XB_TOP      3328
#define XB_TOPGEN   3392
#define XCD_BAR_WORDS 3456
#define XB_SPIN_CAP (1u << 18)
__device__ __forceinline__ unsigned xb_ld(unsigned* p)              { return __hip_atomic_load(p, __ATOMIC_RELAXED, __HIP_MEMORY_SCOPE_AGENT); }
__device__ __forceinline__ unsigned xb_add(unsigned* p, unsigned v) { return __hip_atomic_fetch_add(p, v, __ATOMIC_RELAXED, __HIP_MEMORY_SCOPE_AGENT); }
__device__ __forceinline__ unsigned xb_xcc_id() { return (unsigned)__builtin_amdgcn_s_getreg((3 << 11) | 20) & 0xFu; }
#define XB_SPIN(cond, bar) do { unsigned _sp = 0; while (cond) { __builtin_amdgcn_s_sleep(1); \
    if ((++_sp & 255u) == 0u) { if (xb_ld(&(bar)[XB_TMO])) break; if (_sp > XB_SPIN_CAP) { atomicAdd(&(bar)[XB_TMO], 1u); break; } } } } while (0)
struct XcdBarrier { unsigned* bar; unsigned x; volatile LAS unsigned* st; };
__device__ __forceinline__ XcdBarrier xcd_barrier_post(unsigned* bar, volatile LAS unsigned* st) {
    XcdBarrier b; b.bar = bar; b.x = xb_xcc_id(); b.st = st;
    if (threadIdx.x == 0) (void)xb_add(&bar[XB_XCNT(b.x)], 1u);
    return b;
}
__device__ __forceinline__ void xcd_barrier_complete(unsigned* bar, unsigned x, unsigned& nloc, unsigned& nx) {
    const unsigned G = gridDim.x * gridDim.y * gridDim.z;
    unsigned sum, cnt, mine, sp = 0u;
    for (;;) {
        sum = 0u; cnt = 0u; mine = 0u;
#pragma unroll
        for (unsigned j = 0; j < 16; ++j) { const unsigned c = xb_ld(&bar[XB_XCNT(j)]); sum += c; cnt += (c > 0u) ? 1u : 0u; mine = (j == x) ? c : mine; }
        if (sum == G) break;
        __builtin_amdgcn_s_sleep(1);
        if ((++sp & 255u) == 0u) { if (xb_ld(&bar[XB_TMO])) break; if (sp > XB_SPIN_CAP) { atomicAdd(&bar[XB_TMO], 1u); break; } }
    }
    nloc = mine > 0u ? mine : 1u; nx = cnt > 0u ? cnt : 1u;
}
__device__ __forceinline__ void xcd_barrier(const XcdBarrier& b) {
    asm volatile("s_waitcnt vmcnt(0)" ::: "memory");
    __syncthreads();
    if (threadIdx.x == 0) {
        unsigned* bar = b.bar;
        __builtin_amdgcn_s_waitcnt(0);
        unsigned nloc = b.st[0], nx = b.st[1];
        if (nloc == 0u) { xcd_barrier_complete(bar, b.x, nloc, nx); b.st[0] = nloc; b.st[1] = nx; }
        const unsigned old = xb_add(&bar[XB_XSUB(b.x)], 1u);
        const unsigned gen = old / nloc;
        if (old + 1u == (gen + 1u) * nloc) {
            __builtin_amdgcn_fence(__ATOMIC_RELEASE, "agent");
            asm volatile("s_waitcnt vmcnt(0)" ::: "memory");
            const unsigned og = xb_add(&bar[XB_TOP], 1u);
            const unsigned tg = og / nx;
            if (og + 1u == (tg + 1u) * nx) xb_add(&bar[XB_TOPGEN], 1u);
            else XB_SPIN(xb_ld(&bar[XB_TOPGEN]) == tg, bar);
            __builtin_amdgcn_fence(__ATOMIC_ACQUIRE, "agent");
            xb_add(&bar[XB_XGEN(b.x)], 1u);
            asm volatile("s_waitcnt vmcnt(0)" ::: "memory");
        } else {
            XB_SPIN(xb_ld(&bar[XB_XGEN(b.x)]) == gen, bar);
            __builtin_amdgcn_fence(__ATOMIC_ACQUIRE, "agent");
            asm volatile("s_waitcnt vmcnt(0)" ::: "memory");
        }
    }
    __syncthreads();
}

namespace pg8 {
constexpr int BM = 256, BK = 64, HALF = 128, HTB = HALF * BK * 2, STAGE_BYTES = 8 * HTB;
__host__ __device__ __forceinline__ int lds_byte(int r, int c) { const int st = (r >> 4) * 2 + (c >> 5), rr = r & 15, cc = c & 31, ob = rr * 64 + cc * 2; return st * 1024 + (ob ^ (((ob >> 9) & 1) << 5)); }
__host__ __device__ __forceinline__ void stage_rc(int b, int& R, int& C) { const int st = b / 1024, sb = b % 1024, swz = sb ^ (((sb >> 9) & 1) << 5); R = (st >> 1) * 16 + swz / 64; C = (st & 1) * 32 + (swz % 64) / 2; }
__host__ __device__ __forceinline__ int perm32(int rho) { const int n = rho >> 4, i = rho & 15; return 8 * (i >> 2) + 4 * n + (i & 3); }

struct Unit { int pm, pn, ex; };
struct Gemm { const bf16* A; int lda; int acol; const int* gather; const bf16* Bt; size_t bex; int K; int ldb; int bcol; };

struct DenseOrder {
    int nM, nN, nwg, G, c;
    __device__ __forceinline__ void init(int M, int N, int G_, int c_) { nM = M / BM; nN = N / BM; nwg = nM * nN; G = G_; c = c_; }
    __device__ __forceinline__ bool next(int i, Unit& u) const {
        const long L = (long)i * G + c; if (L >= nwg) return false;
        int wgid = (int)L; { const int q = nwg / 8, r = nwg % 8, xcd = wgid % 8, off = wgid / 8; wgid = (xcd < r ? xcd * (q + 1) : r * (q + 1) + (xcd - r) * q) + off; }
        const int nig = 8 * nN, gid = wgid / nig, fm = gid * 8, gsz = (nM - fm) < 8 ? (nM - fm) : 8;
        u.pm = fm + ((wgid % nig) % gsz); u.pn = (wgid % nig) / gsz; u.ex = 0; return true;
    }
};
struct MoeOrder {
    const int* blke; int nunits, G, vc;
    __device__ __forceinline__ void init(const int* blke_, int nblk, int G_, int c_) { blke = blke_; nunits = nblk * 4; G = G_; vc = (G_ % 8 == 0) ? (c_ % 8) * (G_ / 8) + c_ / 8 : c_; }
    __device__ __forceinline__ bool next(int i, Unit& u) const {
        const int L = i * G + vc; if (L >= nunits) return false;
        u.pm = L >> 2; u.pn = L & 3; u.ex = __builtin_amdgcn_readfirstlane(blke[u.pm]); return true;
    }
};

template <bool GATHER>
__device__ __forceinline__ void a_offsets(const Gemm& g, const Unit& u, const int (&R)[2], const int (&C)[2], unsigned (&vA)[2][2]) {
#pragma unroll
    for (int h = 0; h < 2; ++h)
#pragma unroll
        for (int i = 0; i < 2; ++i) { int row = u.pm * BM + h * HALF + R[i]; if (GATHER) row = g.gather[row]; vA[h][i] = (unsigned)(((size_t)row * g.lda + C[i]) * 2u); }
}

template <int N> __device__ __forceinline__ void wait_vm() { asm volatile("s_waitcnt vmcnt(%0)" :: "n"(N) : "memory"); }
template <class Epi, class Sched, bool GATHER, bool FP8 = false>
__device__ __forceinline__ void gemm_phase(LAS unsigned char* lds, const Gemm g, const Sched& S, const Epi& E, int wave_sgpr) {
    int tid_ = wave_sgpr * 64 + (int)__builtin_amdgcn_mbcnt_hi(~0u, __builtin_amdgcn_mbcnt_lo(~0u, 0u)); asm volatile("" : "+v"(tid_));
    const int tid = tid_, wid = __builtin_amdgcn_readfirstlane(tid >> 6), lane = tid & 63, wr = wid >> 2, wc = wid & 3, fr = lane & 15, fq = lane >> 4;
    int Kop_ = g.K; asm volatile("" : "+s"(Kop_));
    const int K = Kop_, nt = K / BK;
    int Rr[2], Cc[2]; unsigned voffB[2], voffA[2];
#pragma unroll
    for (int i = 0; i < 2; ++i) { int R, C; stage_rc(tid * 16 + i * 8192, R, C); const int Rb = Epi::PERM ? ((R & ~31) + perm32(R & 31)) : R; Rr[i] = R; Cc[i] = C; voffB[i] = (unsigned)(Rb * g.ldb + C) * 2u; voffA[i] = (unsigned)(R * g.lda + C) * 2u; }
    const size_t kstep = (size_t)(BK * 2);
    const size_t hstepB = (size_t)HALF * g.ldb * 2;
    const size_t hstepA = (size_t)HALF * g.lda * 2, tstepA = 2 * hstepA;
    const unsigned ldsw = (unsigned)wid * 1024u;
    const int aoff = lds_byte(wr * 64 + fr, fq * 8), boff = lds_byte(wc * 32 + fr, fq * 8);
#define PG8_SA(b, h) (((b) * 2 + (h)) * HTB)
#define PG8_SB(b, h) ((4 + (b) * 2 + (h)) * HTB)
#define PG8_STAGE_B(bufoff, gbase) do { _Pragma("unroll") for (int _i = 0; _i < 2; ++_i) \
        __builtin_amdgcn_global_load_lds((const unsigned*)((const char*)(gbase) + voffB[_i]), (LAS unsigned*)(lds + (bufoff) + ldsw + _i * 8192), 16, 0, 0); } while (0)
#define PG8_STAGE_A(bufoff, uptr, v0, v1) do { \
        __builtin_amdgcn_global_load_lds((const unsigned*)((uptr) + (v0)), (LAS unsigned*)(lds + (bufoff) + ldsw), 16, 0, 0); \
        __builtin_amdgcn_global_load_lds((const unsigned*)((uptr) + (v1)), (LAS unsigned*)(lds + (bufoff) + ldsw + 8192), 16, 0, 0); } while (0)
#define PG8_STAGE_A_CUR(bufoff, kb, h) do { if constexpr (GATHER) { PG8_STAGE_A(bufoff, Abase + (kb), vAc[h][0], vAc[h][1]); } else { PG8_STAGE_A(bufoff, cA + (kb) + (h) * hstepA, voffA[0], voffA[1]); } } while (0)
#define PG8_STAGE_A_NXT(bufoff, kb, h) do { if constexpr (GATHER) { PG8_STAGE_A(bufoff, Abase + (kb), ((h) ? w10 : w00), ((h) ? w11 : w01)); } else { PG8_STAGE_A(bufoff, a2 + (kb) + (h) * hstepA, voffA[0], voffA[1]); } } while (0)
#define PG8_LDA(dst, b, h) do { _Pragma("unroll") for (int m = 0; m < 4; ++m) { const v4i_ lo_ = *(const LAS v4i_*)(lds + PG8_SA(b, h) + aoff + m * 2048), hi_ = *(const LAS v4i_*)(lds + PG8_SA(b, h) + aoff + m * 2048 + 1024); dst[m] = __builtin_shufflevector(lo_, hi_, 0, 1, 2, 3, 4, 5, 6, 7); } } while (0)
#define PG8_LDB(dst, b, h) do { _Pragma("unroll") for (int n = 0; n < 2; ++n) { const v4i_ lo_ = *(const LAS v4i_*)(lds + PG8_SB(b, h) + boff + n * 2048), hi_ = *(const LAS v4i_*)(lds + PG8_SB(b, h) + boff + n * 2048 + 1024); dst[n] = __builtin_shufflevector(lo_, hi_, 0, 1, 2, 3, 4, 5, 6, 7); } } while (0)
#define PG8_K0(v) __builtin_bit_cast(bf16x8, __builtin_shufflevector(v, v, 0, 1, 2, 3))
#define PG8_K1(v) __builtin_bit_cast(bf16x8, __builtin_shufflevector(v, v, 4, 5, 6, 7))
#define PG8_MMA(ai, bj, At, Bt) do { __builtin_amdgcn_s_setprio(1); _Pragma("unroll") for (int m = 0; m < 4; ++m) _Pragma("unroll") for (int n = 0; n < 2; ++n) { \
        if constexpr (FP8) {   \
            asm volatile("v_mfma_scale_f32_16x16x128_f8f6f4 %0, %1, %2, %0, %3, %3 op_sel_hi:[0,0,0]" : "+v"(acc[ai][bj][m][n]) : "v"(Bt[n]), "v"(At[m]), "v"(one_scale)); } \
        else { acc[ai][bj][m][n] = __builtin_amdgcn_mfma_f32_16x16x32_bf16(PG8_K0(Bt[n]), PG8_K0(At[m]), acc[ai][bj][m][n], 0, 0, 0); acc[ai][bj][m][n] = __builtin_amdgcn_mfma_f32_16x16x32_bf16(PG8_K1(Bt[n]), PG8_K1(At[m]), acc[ai][bj][m][n], 0, 0, 0); } } \
        __builtin_amdgcn_s_setprio(0); } while (0)
#define PG8_WAIT_V(n) asm volatile("s_waitcnt vmcnt(" #n ")" ::: "memory")
#define PG8_WAIT_L(n) asm volatile("s_waitcnt lgkmcnt(" #n ")" ::: "memory")
#define PG8_BAR __builtin_amdgcn_s_barrier()
#define PG8_SCHED __builtin_amdgcn_sched_barrier(0)
    Unit cur, nxt; int ui = 0;
    if (!S.next(0, cur)) return;
    f32x4 acc[2][2][4][2];
#pragma unroll
    for (int a = 0; a < 2; ++a)
#pragma unroll
        for (int b = 0; b < 2; ++b)
#pragma unroll
            for (int m = 0; m < 4; ++m)
#pragma unroll
                for (int n = 0; n < 2; ++n) acc[a][b][m][n] = (f32x4){0.f, 0.f, 0.f, 0.f};
    typedef int v4i_ __attribute__((ext_vector_type(4))); typedef int v8i_ __attribute__((ext_vector_type(8)));
    v8i_ At[4], B0[2], B1[2];
    int one_scale = 0x7f7f7f7f; asm volatile("" : "+v"(one_scale));
    const char* Abase = (const char*)g.A + (size_t)g.acol * 2;
    const char* cA = Abase + (size_t)cur.pm * tstepA;
    unsigned vAc[2][2], vAn[2][2];
    if constexpr (GATHER) a_offsets<GATHER>(g, cur, Rr, Cc, vAc);
    const char* cB = (const char*)g.Bt + ((size_t)cur.ex * g.bex + (size_t)cur.pn * BM * g.ldb + g.bcol) * 2;
    PG8_STAGE_B(PG8_SB(0, 0), cB); PG8_STAGE_A_CUR(PG8_SA(0, 0), 0, 0); PG8_STAGE_B(PG8_SB(0, 1), cB + hstepB); PG8_STAGE_A_CUR(PG8_SA(0, 1), 0, 1);
    if (wr == 1) PG8_BAR;
    PG8_WAIT_V(4); PG8_BAR;
    PG8_STAGE_B(PG8_SB(1, 0), cB + kstep); PG8_STAGE_A_CUR(PG8_SA(1, 0), kstep, 0); PG8_STAGE_B(PG8_SB(1, 1), cB + hstepB + kstep);
    PG8_WAIT_V(6); PG8_BAR;
    for (;;) {
        const bool has_next = S.next(ui + 1, nxt);
        const char* nB = cB; const char* nA = cA;
        if (has_next) { if constexpr (GATHER) a_offsets<GATHER>(g, nxt, Rr, Cc, vAn); nA = Abase + (size_t)nxt.pm * tstepA; nB = (const char*)g.Bt + ((size_t)nxt.ex * g.bex + (size_t)nxt.pn * BM * g.ldb + g.bcol) * 2; }
        else if constexpr (GATHER) {
#pragma unroll
            for (int h = 0; h < 2; ++h)
#pragma unroll
                for (int i = 0; i < 2; ++i) vAn[h][i] = vAc[h][i];
        }
#pragma unroll 1
        for (int t = 0; t < nt; t += 2) {
            const bool last = (t == nt - 2);
            const size_t k1 = (size_t)(t + 1) * kstep;
            const size_t k2 = last ? (size_t)0 : (size_t)(t + 2) * kstep, k3 = k2 + kstep;
            unsigned w00 = 0, w01 = 0, w10 = 0, w11 = 0;
            if constexpr (GATHER) { w00 = last ? vAn[0][0] : vAc[0][0]; w01 = last ? vAn[0][1] : vAc[0][1]; w10 = last ? vAn[1][0] : vAc[1][0]; w11 = last ? vAn[1][1] : vAc[1][1]; }
            const char* a2 = last ? nA : cA;
            const char* b2 = last ? nB : cB + (size_t)(t + 2) * kstep; const char* b3 = b2 + kstep;
            (void)w00; (void)w01; (void)w10; (void)w11; (void)a2;
            PG8_LDB(B0, 0, 0); PG8_SCHED; PG8_LDA(At, 0, 0); PG8_STAGE_A_CUR(PG8_SA(1, 1), k1, 1);
            PG8_WAIT_L(8); PG8_BAR; PG8_WAIT_L(0); PG8_MMA(0, 0, At, B0); PG8_BAR; PG8_SCHED;
            PG8_LDB(B1, 0, 1); PG8_STAGE_B(PG8_SB(0, 0), b2);
            PG8_BAR; PG8_WAIT_L(0); PG8_MMA(0, 1, At, B1); PG8_BAR;
            PG8_LDA(At, 0, 1); PG8_STAGE_A_NXT(PG8_SA(0, 0), k2, 0);
            PG8_BAR; PG8_WAIT_L(0); PG8_MMA(1, 0, At, B0); PG8_BAR; PG8_SCHED;
            PG8_STAGE_B(PG8_SB(0, 1), b2 + hstepB);
            const bool after_epi = (Epi::NST > 0) && (t == 0) && (ui > 0);
            if (after_epi) wait_vm<8 + Epi::NST>(); else PG8_WAIT_V(6);
            PG8_BAR; PG8_MMA(1, 1, At, B1); PG8_BAR;
            PG8_LDB(B0, 1, 0); PG8_SCHED; PG8_LDA(At, 1, 0); PG8_STAGE_A_NXT(PG8_SA(0, 1), k2, 1);
            PG8_WAIT_L(8); PG8_BAR; PG8_WAIT_L(0); PG8_MMA(0, 0, At, B0); PG8_BAR; PG8_SCHED;
            PG8_LDB(B1, 1, 1); PG8_STAGE_B(PG8_SB(1, 0), b3);
            PG8_BAR; PG8_WAIT_L(0); PG8_MMA(0, 1, At, B1);
            if (after_epi) PG8_WAIT_V(10);
            PG8_BAR;
            PG8_LDA(At, 1, 1); PG8_STAGE_A_NXT(PG8_SA(1, 0), k3, 0);
            PG8_BAR; PG8_WAIT_L(0); PG8_MMA(1, 0, At, B0); PG8_BAR; PG8_SCHED;
            PG8_STAGE_B(PG8_SB(1, 1), b3 + hstepB);
            PG8_WAIT_V(6); PG8_BAR; PG8_MMA(1, 1, At, B1); PG8_BAR;
        }
        if (wr == 0) PG8_BAR;
        if constexpr (FP8) asm volatile("s_nop 15\n\ts_nop 15" ::: "memory");
        E(acc, cur, wr, wc, fr, fq);
        if (!has_next) break;
#pragma unroll
        for (int a = 0; a < 2; ++a)
#pragma unroll
            for (int b = 0; b < 2; ++b)
#pragma unroll
                for (int m = 0; m < 4; ++m)
#pragma unroll
                    for (int n = 0; n < 2; ++n) acc[a][b][m][n] = (f32x4){0.f, 0.f, 0.f, 0.f};
        cur = nxt; cB = nB; cA = nA; ++ui;
        if (wr == 1) PG8_BAR;
        if constexpr (GATHER) {
#pragma unroll
            for (int h = 0; h < 2; ++h)
#pragma unroll
                for (int i = 0; i < 2; ++i) vAc[h][i] = vAn[h][i];
        }
    }
    PG8_WAIT_V(0);
    PG8_BAR;
#undef PG8_SA
#undef PG8_SB
#undef PG8_STAGE_A
#undef PG8_STAGE_A_CUR
#undef PG8_STAGE_A_NXT
#undef PG8_STAGE_B
#undef PG8_LDA
#undef PG8_LDB
#undef PG8_MMA
#undef PG8_K0
#undef PG8_K1
#undef PG8_WAIT_V
#undef PG8_WAIT_L
#undef PG8_BAR
#undef PG8_SCHED
}

struct EpiBf16Plain {
    static constexpr bool PERM = true; static constexpr int NST = 16;
    bf16* O; int ldc;
    __device__ __forceinline__ void operator()(const f32x4 (&acc)[2][2][4][2], const Unit& u, int wr, int wc, int fr, int fq) const {
        asm volatile("" : "+v"(fr), "+v"(fq));
        const int row0 = u.pm * BM + wr * 64 + fr, col0 = u.pn * BM + wc * 32 + 8 * fq;
#pragma unroll
        for (int ai = 0; ai < 2; ++ai)
#pragma unroll
            for (int m = 0; m < 4; ++m) { bf16* rowp = O + (size_t)(row0 + ai * HALF + m * 16) * ldc + col0;
#pragma unroll
                for (int bj = 0; bj < 2; ++bj) { const f32x4 v0 = acc[ai][bj][m][0], v1 = acc[ai][bj][m][1];
                    u32x4 w; w.x = cvtpk(v0[0], v0[1]); w.y = cvtpk(v0[2], v0[3]); w.z = cvtpk(v1[0], v1[1]); w.w = cvtpk(v1[2], v1[3]);
                    *(u32x4*)(rowp + bj * HALF) = w; } }
    }
};
struct EpiHgIn {
    static constexpr bool PERM = true; static constexpr int NST = 16;
    bf16* O; const float* lb;
    __device__ __forceinline__ void operator()(const f32x4 (&acc)[2][2][4][2], const Unit& u, int wr, int wc, int fr, int fq) const {
        asm volatile("" : "+v"(fr), "+v"(fq));
        const int row0 = u.pm * BM + wr * 64 + fr, col0 = u.pn * BM + wc * 32 + 8 * fq;
        const int typ = u.pn >> 2;
        float lbv[2][8];
#pragma unroll
        for (int bj = 0; bj < 2; ++bj)
#pragma unroll
            for (int j = 0; j < 8; ++j) lbv[bj][j] = (typ == 1 || typ == 2) ? lb[(typ - 1) * 1024 + ((col0 + bj * HALF + j) & 1023)] : 0.f;
#pragma unroll
        for (int ai = 0; ai < 2; ++ai)
#pragma unroll
            for (int m = 0; m < 4; ++m) { bf16* rowp = O + (size_t)(row0 + ai * HALF + m * 16) * 5120 + col0;
#pragma unroll
                for (int bj = 0; bj < 2; ++bj) { float x[8];
#pragma unroll
                    for (int j = 0; j < 4; ++j) { x[j] = acc[ai][bj][m][0][j]; x[4 + j] = acc[ai][bj][m][1][j]; }
                    if (typ == 0) {
#pragma unroll
                        for (int j = 0; j < 8; ++j) x[j] = silu_f(x[j]);
                    } else if (typ == 1 || typ == 2) {
#pragma unroll
                        for (int j = 0; j < 8; ++j) { const float sg = fast_rcp(1.0f + fast_exp(-x[j])); const float f = lbv[bj][j] + (1.0f - lbv[bj][j]) * sg; x[j] = f; }
                    }
                    u32x4 w; w.x = cvtpk(x[0], x[1]); w.y = cvtpk(x[2], x[3]); w.z = cvtpk(x[4], x[5]); w.w = cvtpk(x[6], x[7]);
                    *(u32x4*)(rowp + bj * HALF) = w; } }
    }
};
struct EpiResid {
    static constexpr bool PERM = true; static constexpr int NST = 8;
    const float* base_ctx; const float* base_lat; const bf16* base16; bf16* out; const float* mod; int lat_only; float ascale;
    __device__ __forceinline__ void operator()(const f32x4 (&acc)[2][2][4][2], const Unit& u, int wr, int wc, int fr, int fq) const {
        asm volatile("" : "+v"(fr), "+v"(fq));
        int bidx; size_t srow0, drow0;
        if (lat_only) { bidx = u.pm >> 3; srow0 = (size_t)u.pm * BM; drow0 = srow0; }
        else if (u.pm < 32) { bidx = 32; srow0 = (size_t)u.pm * BM; drow0 = srow0; }
        else { bidx = (u.pm - 32) >> 3; srow0 = (size_t)(u.pm - 32) * BM; drow0 = (size_t)u.pm * BM; }
        const float* src = (!lat_only && u.pm < 32) ? base_ctx : base_lat;
        const float* gt = mod + (size_t)bidx * 6144;
        const int rl0 = wr * 64 + fr, col0 = u.pn * BM + wc * 32 + 8 * fq;
        f32x4 gate[2][2];
#pragma unroll
        for (int bj = 0; bj < 2; ++bj) { const int col = col0 + bj * HALF; gate[bj][0] = *(const f32x4*)(gt + col) * ascale; gate[bj][1] = *(const f32x4*)(gt + col + 4) * ascale; }
        if (base16) {
            u32x4 bw[2][4][2];
#pragma unroll
            for (int ai = 0; ai < 2; ++ai)
#pragma unroll
                for (int m = 0; m < 4; ++m)
#pragma unroll
                    for (int bj = 0; bj < 2; ++bj) bw[ai][m][bj] = *(const u32x4*)(base16 + (srow0 + rl0 + ai * HALF + m * 16) * D + col0 + bj * HALF);
#pragma unroll
            for (int ai = 0; ai < 2; ++ai)
#pragma unroll
                for (int m = 0; m < 4; ++m) { const int rl = rl0 + ai * HALF + m * 16;
#pragma unroll
                    for (int bj = 0; bj < 2; ++bj) { const u32x4 w0 = bw[ai][m][bj];
                        const f32x4 b0 = (f32x4){bflo(w0.x), bfhi(w0.x), bflo(w0.y), bfhi(w0.y)}, b1 = (f32x4){bflo(w0.z), bfhi(w0.z), bflo(w0.w), bfhi(w0.w)};
                        const f32x4 v0 = b0 + gate[bj][0] * acc[ai][bj][m][0], v1 = b1 + gate[bj][1] * acc[ai][bj][m][1];
                        u32x4 w; w.x = cvtpk(v0[0], v0[1]); w.y = cvtpk(v0[2], v0[3]); w.z = cvtpk(v1[0], v1[1]); w.w = cvtpk(v1[2], v1[3]);
                        *(u32x4*)(out + (drow0 + rl) * D + col0 + bj * HALF) = w; } }
        } else {
#pragma unroll
            for (int ai = 0; ai < 2; ++ai) {
                f32x4 bb[4][2][2];
#pragma unroll
                for (int m = 0; m < 4; ++m)
#pragma unroll
                    for (int bj = 0; bj < 2; ++bj) { const float* sp = src + (srow0 + rl0 + ai * HALF + m * 16) * D + col0 + bj * HALF; bb[m][bj][0] = *(const f32x4*)sp; bb[m][bj][1] = *(const f32x4*)(sp + 4); }
#pragma unroll
                for (int m = 0; m < 4; ++m) { const int rl = rl0 + ai * HALF + m * 16;
#pragma unroll
                    for (int bj = 0; bj < 2; ++bj) { const f32x4 v0 = bb[m][bj][0] + gate[bj][0] * acc[ai][bj][m][0], v1 = bb[m][bj][1] + gate[bj][1] * acc[ai][bj][m][1];
                        u32x4 w; w.x = cvtpk(v0[0], v0[1]); w.y = cvtpk(v0[2], v0[3]); w.z = cvtpk(v1[0], v1[1]); w.w = cvtpk(v1[2], v1[3]);
                        *(u32x4*)(out + (drow0 + rl) * D + col0 + bj * HALF) = w; } }
                asm volatile("" ::: "memory"); }
        }
    }
};
struct EpiSwiGLU {
    static constexpr bool PERM = true; static constexpr int NST = 8;
    bf16* O;
    __device__ __forceinline__ void operator()(const f32x4 (&acc)[2][2][4][2], const Unit& u, int wr, int wc, int fr, int fq) const {
        asm volatile("" : "+v"(fr), "+v"(fq));
        const int row0 = u.pm * BM + wr * 64 + fr, col0 = u.pn * 128 + wc * 32 + 8 * fq;
#pragma unroll
        for (int ai = 0; ai < 2; ++ai)
#pragma unroll
            for (int m = 0; m < 4; ++m) { bf16* rowp = O + (size_t)(row0 + ai * HALF + m * 16) * FF + col0; float x[8];
#pragma unroll
                for (int n = 0; n < 2; ++n)
#pragma unroll
                    for (int j = 0; j < 4; ++j) x[n * 4 + j] = silu_f(acc[ai][0][m][n][j]) * acc[ai][1][m][n][j];
                u32x4 w; w.x = cvtpk(x[0], x[1]); w.y = cvtpk(x[2], x[3]); w.z = cvtpk(x[4], x[5]); w.w = cvtpk(x[6], x[7]);
                *(u32x4*)rowp = w; }
    }
};
struct EpiDown {
    static constexpr bool PERM = true; static constexpr int NST = 16;
    bf16* O; const float* wrow;
    __device__ __forceinline__ void operator()(const f32x4 (&acc)[2][2][4][2], const Unit& u, int wr, int wc, int fr, int fq) const {
        asm volatile("" : "+v"(fr), "+v"(fq));
        const int row0 = u.pm * BM + wr * 64 + fr, col0 = u.pn * BM + wc * 32 + 8 * fq;
#pragma unroll
        for (int ai = 0; ai < 2; ++ai)
#pragma unroll
            for (int m = 0; m < 4; ++m) { const int row = row0 + ai * HALF + m * 16; const float s = wrow[row]; bf16* rowp = O + (size_t)row * D + col0;
#pragma unroll
                for (int bj = 0; bj < 2; ++bj) { const f32x4 v0 = acc[ai][bj][m][0] * s, v1 = acc[ai][bj][m][1] * s;
                    u32x4 w; w.x = cvtpk(v0[0], v0[1]); w.y = cvtpk(v0[2], v0[3]); w.z = cvtpk(v1[0], v1[1]); w.w = cvtpk(v1[2], v1[3]);
                    *(u32x4*)(rowp + bj * HALF) = w; } }
    }
};
struct EpiC {
    static constexpr bool PERM = true; static constexpr int NST = 16;
    bf16* O; float* ss4; float* ssq;
    __device__ __forceinline__ void operator()(const f32x4 (&acc)[2][2][4][2], const Unit& u, int wr, int wc, int fr, int fq) const {
        asm volatile("" : "+v"(fr), "+v"(fq));
        const int row0 = u.pm * BM + wr * 64 + fr, col0 = u.pn * BM + wc * 32 + 8 * fq;
#pragma unroll
        for (int ai = 0; ai < 2; ++ai)
#pragma unroll
            for (int m = 0; m < 4; ++m) { const int row = row0 + ai * HALF + m * 16; bf16* rowp = O + (size_t)row * 512 + col0;
#pragma unroll
                for (int bj = 0; bj < 2; ++bj) { const f32x4 v0 = acc[ai][bj][m][0], v1 = acc[ai][bj][m][1];
                    u32x4 w; w.x = cvtpk(v0[0], v0[1]); w.y = cvtpk(v0[2], v0[3]); w.z = cvtpk(v1[0], v1[1]); w.w = cvtpk(v1[2], v1[3]);
                    *(u32x4*)(rowp + bj * HALF) = w; }
                if (u.pn == 1) { const f32x4 v0 = acc[ai][0][m][0], v1 = acc[ai][0][m][1];
                    float q = (v0[0] * v0[0] + v0[1] * v0[1]) + (v0[2] * v0[2] + v0[3] * v0[3]) + (v1[0] * v1[0] + v1[1] * v1[1]) + (v1[2] * v1[2] + v1[3] * v1[3]);
                    q += __shfl_xor(q, 16); q += __shfl_xor(q, 32);
                    if (fq == 0) ss4[(size_t)row * 4 + wc] = q; }
                else { float q = 0.f;
#pragma unroll
                    for (int bj = 0; bj < 2; ++bj) { const f32x4 v0 = acc[ai][bj][m][0], v1 = acc[ai][bj][m][1]; q += (v0[0] * v0[0] + v0[1] * v0[1]) + (v0[2] * v0[2] + v0[3] * v0[3]) + (v1[0] * v1[0] + v1[1] * v1[1]) + (v1[2] * v1[2] + v1[3] * v1[3]); }
                    q += __shfl_xor(q, 16); q += __shfl_xor(q, 32);
                    if (fq == 0) ssq[(size_t)row * 4 + wc] = q; } }
    }
};
struct EpiKf {
    static constexpr bool PERM = true; static constexpr int NST = 0;
    bf16* Kf; const bf16* C; const float* ss4; const float* gk; const LAS float* ropel;
    __device__ __forceinline__ void operator()(const f32x4 (&acc)[2][2][4][2], const Unit& u, int wr, int wc, int fr, int fq) const {
        asm volatile("" : "+v"(fr), "+v"(fq));
        const int h = 4 * u.pn + wc;
        int b, pos0; if (u.pm < 32) { b = u.pm; pos0 = 0; } else { b = (u.pm - 32) >> 3; pos0 = CTXL + ((u.pm - 32) & 7) * 256; }
        float g0[8], g1[8], gr[8];
#pragma unroll
        for (int j = 0; j < 8; ++j) { g0[j] = gk[8 * fq + j]; g1[j] = gk[32 + 8 * fq + j]; gr[j] = gk[64 + 8 * fq + j]; }
        const int ax = fq >> 1, odd = fq & 1;
#pragma unroll
        for (int ai = 0; ai < 2; ++ai) {
            float rkv4[4]; u32x4 rw4[4];
#pragma unroll
            for (int m = 0; m < 4; ++m) { const int row = u.pm * BM + ai * HALF + wr * 64 + m * 16 + fr;
                const f32x4 s4 = *(const f32x4*)(ss4 + (size_t)row * 4); rkv4[m] = 1.0f / sqrtf(((s4.x + s4.y) + (s4.z + s4.w)) * (1.0f / 128.0f) + EPS);
                rw4[m] = *(const u32x4*)(C + (size_t)row * 512 + 384 + 8 * fq); }
#pragma unroll
            for (int m = 0; m < 4; ++m) { const int rl = ai * HALF + wr * 64 + m * 16 + fr; const int pos = pos0 + rl;
                const float rkv = rkv4[m]; const u32x4 rw = rw4[m];
                float kn[16], kr[8];
#pragma unroll
                for (int bj = 0; bj < 2; ++bj)
#pragma unroll
                    for (int j = 0; j < 4; ++j) { kn[8 * bj + j] = acc[ai][bj][m][0][j] * rkv; kn[8 * bj + 4 + j] = acc[ai][bj][m][1][j] * rkv; }
#pragma unroll
                for (int j = 0; j < 4; ++j) { kr[2 * j] = bflo(rw[j]); kr[2 * j + 1] = bfhi(rw[j]); }
                float ss = 0.f;
#pragma unroll
                for (int j = 0; j < 16; ++j) ss += kn[j] * kn[j];
#pragma unroll
                for (int j = 0; j < 8; ++j) ss += kr[j] * kr[j];
                ss += __shfl_xor(ss, 16); ss += __shfl_xor(ss, 32);
                const float rn = 1.0f / sqrtf(ss * (1.0f / 96.0f) + EPS);
#if ATT_FP8
                unsigned char* kd8 = (unsigned char*)Kf + ((size_t)(b * NH + h) * KVLEN + pos) * 128 + 32 * (fq & 1) + 8 * (fq >> 1);
                { u32x2 w; w.x = pk4_fp8(kn[0] * rn * g0[0], kn[1] * rn * g0[1], kn[2] * rn * g0[2], kn[3] * rn * g0[3]); w.y = pk4_fp8(kn[4] * rn * g0[4], kn[5] * rn * g0[5], kn[6] * rn * g0[6], kn[7] * rn * g0[7]); *(u32x2*)kd8 = w;
                  w.x = pk4_fp8(kn[8] * rn * g1[0], kn[9] * rn * g1[1], kn[10] * rn * g1[2], kn[11] * rn * g1[3]); w.y = pk4_fp8(kn[12] * rn * g1[4], kn[13] * rn * g1[5], kn[14] * rn * g1[6], kn[15] * rn * g1[7]); *(u32x2*)(kd8 + 16) = w;
                  *(u32x2*)(kd8 + 80) = (u32x2){0u, 0u}; }
#else
                bf16* kd = Kf + ((size_t)(b * NH + h) * KVLEN + pos) * QK;
                { u32x4 w; w.x = cvtpk(kn[0] * rn * g0[0], kn[1] * rn * g0[1]); w.y = cvtpk(kn[2] * rn * g0[2], kn[3] * rn * g0[3]); w.z = cvtpk(kn[4] * rn * g0[4], kn[5] * rn * g0[5]); w.w = cvtpk(kn[6] * rn * g0[6], kn[7] * rn * g0[7]); *(u32x4*)(kd + 8 * fq) = w;
                  w.x = cvtpk(kn[8] * rn * g1[0], kn[9] * rn * g1[1]); w.y = cvtpk(kn[10] * rn * g1[2], kn[11] * rn * g1[3]); w.z = cvtpk(kn[12] * rn * g1[4], kn[13] * rn * g1[5]); w.w = cvtpk(kn[14] * rn * g1[6], kn[15] * rn * g1[7]); *(u32x4*)(kd + 32 + 8 * fq) = w; }
#endif
                float o8[8];
                const int t = pos - CTXL; const int p = ax ? (t & 63) : (t >> 6);
#pragma unroll
                for (int i = 0; i < 8; ++i) { const float mine = kr[i] * rn * gr[i]; const float other = __shfl_xor(mine, 16);
                    float cs = 1.f, sn = 0.f; if (u.pm >= 32) { const f32x2_t csn = *(const LAS f32x2_t*)(ropel + (p * 8 + i) * 2); cs = csn.x; sn = csn.y; }
                    o8[i] = mine * cs + (odd ? other : -other) * sn; }
#if ATT_FP8
                { u32x2 w; w.x = pk4_fp8(o8[0], o8[1], o8[2], o8[3]); w.y = pk4_fp8(o8[4], o8[5], o8[6], o8[7]); *(u32x2*)(kd8 + 64) = w; }
#else
                { u32x4 w; w.x = cvtpk(o8[0], o8[1]); w.y = cvtpk(o8[2], o8[3]); w.z = cvtpk(o8[4], o8[5]); w.w = cvtpk(o8[6], o8[7]); *(u32x4*)(kd + 64 + 8 * fq) = w; }
#endif
                asm volatile("" ::: "memory"); } }
    }
};
struct EpiVt {
    static constexpr bool PERM = true; static constexpr int NST = 32;
    bf16* Vt; const float* ss4;
    __device__ __forceinline__ void operator()(const f32x4 (&acc)[2][2][4][2], const Unit& u, int wr, int wc, int fr, int fq) const {
        asm volatile("" : "+v"(fr), "+v"(fq));
        int b, pos0; if (u.pn < 32) { b = u.pn; pos0 = 0; } else { b = (u.pn - 32) >> 3; pos0 = CTXL + ((u.pn - 32) & 7) * 256; }
        const int m8 = 16 * 0;  (void)m8;
        float rk2[2][8];
#pragma unroll
        for (int bj = 0; bj < 2; ++bj) { const int cl = bj * HALF + wc * 32 + 8 * fq;
#pragma unroll
            for (int j = 0; j < 8; ++j) { const f32x4 s4 = *(const f32x4*)(ss4 + (size_t)(u.pn * BM + cl + j) * 4); rk2[bj][j] = 1.0f / sqrtf(((s4.x + s4.y) + (s4.z + s4.w)) * (1.0f / 128.0f) + EPS); }
            asm volatile("" ::: "memory"); }
#pragma unroll
        for (int bj = 0; bj < 2; ++bj) { const int cl = bj * HALF + wc * 32 + 8 * fq;
            float rk[8];
#pragma unroll
            for (int j = 0; j < 8; ++j) rk[j] = rk2[bj][j];
            const int pos = pos0 + cl;
#if ATT_FP8
            const int ub = (pos & ~63) + 16 * ((pos >> 5) & 1) + 4 * ((pos >> 3) & 3);
#pragma unroll
            for (int ai = 0; ai < 2; ++ai)
#pragma unroll
                for (int m = 0; m < 4; ++m) { const int r = u.pm * BM + ai * HALF + wr * 64 + m * 16 + fr; const int h = r >> 6, d = r & 63;
                    unsigned char* vd = (unsigned char*)Vt + ((size_t)(b * NH + h) * VD + d) * KVLEN + ub;
                    const f32x4 v0 = acc[ai][bj][m][0], v1 = acc[ai][bj][m][1];
                    *(unsigned*)vd = pk4_fp8(v0[0] * rk[0], v0[1] * rk[1], v0[2] * rk[2], v0[3] * rk[3]); *(unsigned*)(vd + 32) = pk4_fp8(v1[0] * rk[4], v1[1] * rk[5], v1[2] * rk[6], v1[3] * rk[7]); }
#else
            const int e = (pos >> 3) & 1;
            const int ub = (pos & ~15) + 4 * e;
#pragma unroll
            for (int ai = 0; ai < 2; ++ai)
#pragma unroll
                for (int m = 0; m < 4; ++m) { const int r = u.pm * BM + ai * HALF + wr * 64 + m * 16 + fr; const int h = r >> 6, d = r & 63;
                    bf16* vd = Vt + ((size_t)(b * NH + h) * VD + d) * KVLEN + ub;
                    const f32x4 v0 = acc[ai][bj][m][0], v1 = acc[ai][bj][m][1];
                    u32x2 w0, w1; w0.x = cvtpk(v0[0] * rk[0], v0[1] * rk[1]); w0.y = cvtpk(v0[2] * rk[2], v0[3] * rk[3]); w1.x = cvtpk(v1[0] * rk[4], v1[1] * rk[5]); w1.y = cvtpk(v1[2] * rk[6], v1[3] * rk[7]);
                    *(u32x2*)vd = w0; *(u32x2*)(vd + 8) = w1; }
#endif
            asm volatile("" ::: "memory"); }
    }
};
struct EpiSwiGLU8 {
    static constexpr bool PERM = true; static constexpr int NST = 8;
    unsigned char* O;
    __device__ __forceinline__ void operator()(const f32x4 (&acc)[2][2][4][2], const Unit& u, int wr, int wc, int fr, int fq) const {
        asm volatile("" : "+v"(fr), "+v"(fq));
        const int row0 = u.pm * BM + wr * 64 + fr, col0 = u.pn * 128 + wc * 32 + 8 * fq;
#pragma unroll
        for (int ai = 0; ai < 2; ++ai)
#pragma unroll
            for (int m = 0; m < 4; ++m) { unsigned char* rowp = O + (size_t)(row0 + ai * HALF + m * 16) * FF + col0; float x[8];
#pragma unroll
                for (int n = 0; n < 2; ++n)
#pragma unroll
                    for (int j = 0; j < 4; ++j) x[n * 4 + j] = silu_f(acc[ai][0][m][n][j] * 0.03125f) * (acc[ai][1][m][n][j] * 0.03125f);
                u32x2 w; w.x = pk4_fp8(x[0], x[1], x[2], x[3]); w.y = pk4_fp8(x[4], x[5], x[6], x[7]);
                *(u32x2*)rowp = w; }
    }
};
struct EpiDown8 {
    static constexpr bool PERM = true; static constexpr int NST = 16;
    bf16* O; const float* wrow;
    __device__ __forceinline__ void operator()(const f32x4 (&acc)[2][2][4][2], const Unit& u, int wr, int wc, int fr, int fq) const {
        asm volatile("" : "+v"(fr), "+v"(fq));
        const int row0 = u.pm * BM + wr * 64 + fr, col0 = u.pn * BM + wc * 32 + 8 * fq;
        float sv[8];
#pragma unroll
        for (int i = 0; i < 8; ++i) sv[i] = wrow[row0 + (i >> 2) * HALF + (i & 3) * 16];
#pragma unroll
        for (int ai = 0; ai < 2; ++ai)
#pragma unroll
            for (int m = 0; m < 4; ++m) { const int row = row0 + ai * HALF + m * 16; const float s = sv[ai * 4 + m] * 0.0625f; bf16* rowp = O + (size_t)row * D + col0;
#pragma unroll
                for (int bj = 0; bj < 2; ++bj) { const f32x4 v0 = acc[ai][bj][m][0] * s, v1 = acc[ai][bj][m][1] * s;
                    u32x4 w; w.x = cvtpk(v0[0], v0[1]); w.y = cvtpk(v0[2], v0[3]); w.z = cvtpk(v1[0], v1[1]); w.w = cvtpk(v1[2], v1[3]);
                    *(u32x4*)(rowp + bj * HALF) = w; } }
    }
};
}

struct Args { const float* in[25]; float* out; unsigned char* ws; int ph_lo, ph_hi; };
enum { I_X = 0, I_C, I_CTX, I_CCTX, I_ADAW, I_ADAB, I_NMIX, I_NFFN, I_HGWIN, I_HGLB, I_HGONG, I_HGWOUT, I_MWIN, I_MQNG, I_MKVNG, I_MWQB, I_MWKVB, I_MQQK, I_MKQK, I_MWOUT, I_GRP, I_EXP, I_WG, I_WU, I_WD };

typedef const __attribute__((address_space(4))) Args* KArgs;
struct Frame {
    LAS unsigned char* lds;
    int tid, lane, wave, G, gw, ngw;
    KArgs a;
    unsigned char* ws;
};

__device__ __forceinline__ void cvt_item(const float* W, int ldw, int k0, int n0, bf16* dst, int dst_ld, int dst_row0, const float* gain, int gmask, LAS float* scr, int lane, bool swaprow = false) {
    asm volatile("" : "+v"(lane));
    float tv[32];
#pragma unroll
    for (int i = 0; i < 32; ++i) tv[i] = W[(size_t)(k0 + 2 * i + (lane >> 5)) * ldw + n0 + (lane & 31)];
#pragma unroll
    for (int i = 0; i < 32; ++i) { const int kk = 2 * i + (lane >> 5); float v = tv[i]; if (gain) v *= gain[(k0 + kk) & gmask]; scr[kk * 33 + (lane & 31)] = v; }
    LDS_WAIT(); asm volatile("" ::: "memory");
    const int c = lane & 7;
#pragma unroll
    for (int j = 0; j < 4; ++j) { const int n = (lane >> 3) + 8 * j; const LAS float* s = scr + (8 * c) * 33 + n;
        u32x4 o; o.x = cvtpk(s[0 * 33], s[1 * 33]); o.y = cvtpk(s[2 * 33], s[3 * 33]); o.z = cvtpk(s[4 * 33], s[5 * 33]); o.w = cvtpk(s[6 * 33], s[7 * 33]);
        const int nd = swaprow ? ((n & ~12) | ((n & 4) << 1) | ((n & 8) >> 1)) : n;
        *(u32x4*)(dst + (size_t)(dst_row0 + nd) * dst_ld + k0 + 8 * c) = o; }
    LDS_WAIT(); asm volatile("" ::: "memory");
}
__device__ __forceinline__ void moe_convert(Frame& F, int layer, bf16* dst) {
    LAS float* scr = (LAS float*)(F.lds + F.wave * 16384);
    const float* wg = F.a->in[I_WG] + (size_t)layer * NEXP * D * FF; const float* wu = F.a->in[I_WU] + (size_t)layer * NEXP * D * FF; const float* wd = F.a->in[I_WD] + (size_t)layer * NEXP * FF * D;
    bf16* dgu = dst; bf16* dd = dst + (size_t)NEXP * 1024 * 1024;
    constexpr int IG = (D / 64) * (FF / 32);
    constexpr int IDN = (FF / 64) * (D / 32);
    constexpr int NIT = NEXP * (2 * IG + IDN);
    for (int it = F.gw; it < NIT; it += F.ngw) {
        const int e = it / (2 * IG + IDN); int r = it % (2 * IG + IDN);
        if (r < 2 * IG) { const int up = r >= IG; if (up) r -= IG; const int kb = r / (FF / 32), nb = r % (FF / 32); const int n0 = nb * 32;
            const int drow = (n0 >> 7) * 256 + up * 128 + (n0 & 127);
            cvt_item((up ? wu : wg) + (size_t)e * D * FF, FF, kb * 64, n0, dgu + (size_t)e * 1024 * 1024, 1024, drow, nullptr, 0, scr, F.lane); }
        else { r -= 2 * IG; const int kb = r / (D / 32), nb = r % (D / 32);
            cvt_item(wd + (size_t)e * FF * D, D, kb * 64, nb * 32, dd + (size_t)e * 1024 * 512, 512, nb * 32, nullptr, 0, scr, F.lane); }
    }
}

__device__ __forceinline__ void cvt_item8(const float* W, int ldw, int k0, int n0, unsigned char* dst, int dst_ld, int dst_row0, float sc, LAS float* scr, int lane, const float* gain = nullptr, int gmask = 0) {
    asm volatile("" : "+v"(lane));
    float tv[32];
#pragma unroll
    for (int i = 0; i < 32; ++i) tv[i] = W[(size_t)(k0 + 2 * i + (lane >> 5)) * ldw + n0 + (lane & 31)];
#pragma unroll
    for (int i = 0; i < 32; ++i) { const int kk = 2 * i + (lane >> 5); float v = tv[i] * sc; if (gain) v *= gain[(k0 + kk) & gmask]; scr[kk * 33 + (lane & 31)] = v; }
    LDS_WAIT(); asm volatile("" ::: "memory");
    const int c = lane & 7;
#pragma unroll
    for (int j = 0; j < 4; ++j) { const int n = (lane >> 3) + 8 * j; const LAS float* p = scr + (8 * c) * 33 + n;
        u32x2 o; o.x = pk4_fp8(p[0 * 33], p[1 * 33], p[2 * 33], p[3 * 33]); o.y = pk4_fp8(p[4 * 33], p[5 * 33], p[6 * 33], p[7 * 33]);
        *(u32x2*)(dst + (size_t)(dst_row0 + n) * dst_ld + k0 + 8 * c) = o; }
    LDS_WAIT(); asm volatile("" ::: "memory");
}
struct Cvt8Item { const float* W; unsigned char* dst; int ldw, k0, n0, dst_ld, drow; float sc; };
__device__ __forceinline__ Cvt8Item moe_item8(int it, const float* wg, const float* wu, const float* wd, unsigned char* dgu, unsigned char* dd) {
    constexpr int IG = (D / 64) * (FF / 32), IDN = (FF / 64) * (D / 32);
    const int e = it / (2 * IG + IDN); int r = it % (2 * IG + IDN); Cvt8Item c;
    if (r < 2 * IG) { const int up = r >= IG; if (up) r -= IG; const int kb = r / (FF / 32), nb = r % (FF / 32); const int n0 = nb * 32;
        c.W = (up ? wu : wg) + (size_t)e * D * FF; c.ldw = FF; c.k0 = kb * 64; c.n0 = n0; c.dst = dgu + (size_t)e * 1024 * 1024; c.dst_ld = 1024; c.drow = (n0 >> 7) * 256 + up * 128 + (n0 & 127); c.sc = 32.0f; }
    else { r -= 2 * IG; const int kb = r / (D / 32), nb = r % (D / 32);
        c.W = wd + (size_t)e * FF * D; c.ldw = D; c.k0 = kb * 64; c.n0 = nb * 32; c.dst = dd + (size_t)e * 1024 * 512; c.dst_ld = 512; c.drow = nb * 32; c.sc = 16.0f; }
    return c;
}
__device__ __forceinline__ void moe_convert8(Frame& F, int layer, unsigned char* dst, int it_lo = 0, int it_hi = 1 << 30, int wv = -1, int nwv = 0) {
    LAS float* scr = (LAS float*)(F.lds + F.wave * 16384);
    const float* wg = F.a->in[I_WG] + (size_t)layer * NEXP * D * FF; const float* wu = F.a->in[I_WU] + (size_t)layer * NEXP * D * FF; const float* wd = F.a->in[I_WD] + (size_t)layer * NEXP * FF * D;
    unsigned char* dgu = dst; unsigned char* dd = dst + (size_t)NEXP * 1024 * 1024;
    constexpr int IG = (D / 64) * (FF / 32), IDN = (FF / 64) * (D / 32), NIT = NEXP * (2 * IG + IDN);
    if (wv < 0) { wv = F.gw; nwv = F.ngw; }
    if (it_hi > NIT) it_hi = NIT;
    int it = it_lo + wv; if (it >= it_hi) return;
    int lane = F.lane; asm volatile("" : "+v"(lane));
    float tv[32];
    { const Cvt8Item c = moe_item8(it, wg, wu, wd, dgu, dd);
#pragma unroll
      for (int i = 0; i < 32; ++i) tv[i] = c.W[(size_t)(c.k0 + 2 * i + (lane >> 5)) * c.ldw + c.n0 + (lane & 31)]; }
    for (;;) {
        const Cvt8Item c = moe_item8(it, wg, wu, wd, dgu, dd);
        const int itn = it + nwv; const bool more = itn < it_hi;
        float tn[32];
        if (more) { const Cvt8Item cn = moe_item8(itn, wg, wu, wd, dgu, dd);
#pragma unroll
            for (int i = 0; i < 32; ++i) tn[i] = cn.W[(size_t)(cn.k0 + 2 * i + (lane >> 5)) * cn.ldw + cn.n0 + (lane & 31)]; }
#pragma unroll
        for (int i = 0; i < 32; ++i) scr[(2 * i + (lane >> 5)) * 33 + (lane & 31)] = tv[i] * c.sc;
        LDS_WAIT(); asm volatile("" ::: "memory");
        const int cc = lane & 7;
#pragma unroll
        for (int j = 0; j < 4; ++j) { const int n = (lane >> 3) + 8 * j; const LAS float* pp = scr + (8 * cc) * 33 + n;
            u32x2 o; o.x = pk4_fp8(pp[0 * 33], pp[1 * 33], pp[2 * 33], pp[3 * 33]); o.y = pk4_fp8(pp[4 * 33], pp[5 * 33], pp[6 * 33], pp[7 * 33]);
            *(u32x2*)(c.dst + (size_t)(c.drow + n) * c.dst_ld + c.k0 + 8 * cc) = o; }
        LDS_WAIT(); asm volatile("" ::: "memory");
        if (!more) break;
#pragma unroll
        for (int i = 0; i < 32; ++i) tv[i] = tn[i];
        it = itn;
    }
}

__device__ __forceinline__ float modulate_row(const f32x4 (&v)[4], const float* g, const float* modrow, int sh_chunk, bf16* orow, int lane, unsigned char* orow8 = nullptr) {
    float ss = 0.f;
#pragma unroll
    for (int j = 0; j < 4; ++j) ss += (v[j].x * v[j].x + v[j].y * v[j].y) + (v[j].z * v[j].z + v[j].w * v[j].w);
    const float r = 1.0f / sqrtf(wave_sum(ss) * (1.0f / D) + EPS);
#pragma unroll
    for (int j = 0; j < 4; ++j) { const int col = 4 * lane + 256 * j;
        const f32x4 gg = *(const f32x4*)(g + col), sh = *(const f32x4*)(modrow + sh_chunk * 1024 + col), sc = *(const f32x4*)(modrow + (sh_chunk + 1) * 1024 + col);
        const f32x4 y = (v[j] * r) * gg * (sc + 1.0f) + sh;
        if (orow) { u32x2 w; w.x = cvtpk(y.x, y.y); w.y = cvtpk(y.z, y.w); *(u32x2*)(orow + col) = w; }
        if (orow8) *(unsigned*)(orow8 + col) = pk4_fp8(y.x, y.y, y.z, y.w); }
    return r;
}
__device__ __forceinline__ int mod_row_of(int row) { return row < TC ? 32 : ((row - TC) >> 11); }

__device__ __forceinline__ void phase_prologue(Frame& F) {
    KArgs ap = F.a; unsigned char* ws = F.ws;
    LAS float* scr = (LAS float*)(F.lds + F.wave * 16384);
    {
        constexpr int I1 = 16 * 160, I2 = 16 * 32, I3 = 16 * 13, I4 = 4 * 48, I5 = 2 * 64, I6 = 16 * 32;
        constexpr int NIT = I1 + I2 + I3 + I4 + I5 + I6;
        for (int it = F.gw; it < NIT; it += F.ngw) {
            int r = it;
            if (r < I1) { cvt_item(ap->in[I_HGWIN], 5120, (r / 160) * 64, (r % 160) * 32, (bf16*)(ws + WS_W1T), 1024, (r % 160) * 32, nullptr, 0, scr, F.lane); continue; } r -= I1;
#if HG_FP8
            if (r < I2) { cvt_item8(ap->in[I_HGWOUT], 1024, (r / 32) * 64, (r % 32) * 32, ws + WS_W2T, 1024, (r % 32) * 32, 32.0f, scr, F.lane, ap->in[I_HGONG], 127); continue; } r -= I2;
#else
            if (r < I2) { cvt_item(ap->in[I_HGWOUT], 1024, (r / 32) * 64, (r % 32) * 32, (bf16*)(ws + WS_W2T), 1024, (r % 32) * 32, ap->in[I_HGONG], 127, scr, F.lane); continue; } r -= I2;
#endif
            if (r < I3) { cvt_item(ap->in[I_MWIN], 416, (r / 13) * 64, (r % 13) * 32, (bf16*)(ws + WS_WMIN), 1024, (r % 13) * 32, nullptr, 0, scr, F.lane); continue; } r -= I3;
            if (r < I4) { cvt_item(ap->in[I_MWQB], 1536, (r / 48) * 64, (r % 48) * 32, (bf16*)(ws + WS_WQB), 256, (r % 48) * 32, ap->in[I_MQNG], 255, scr, F.lane, true); continue; } r -= I4;
            if (r < I5) { const int nb = r % 64, h = nb >> 2, part = nb & 3;
                const int drow = (part < 2) ? ((h >> 2) * 256 + part * 128 + (h & 3) * 32) : (1024 + h * 64 + (part - 2) * 32);
                cvt_item(ap->in[I_MWKVB], 2048, (r / 64) * 64, nb * 32, (bf16*)(ws + WS_WKVB), 128, drow, ap->in[I_MKVNG], 127, scr, F.lane); continue; } r -= I5;
#if AO_FP8
            cvt_item8(ap->in[I_MWOUT], 1024, (r / 32) * 64, (r % 32) * 32, ws + WS_W4T, 1024, (r % 32) * 32, 32.0f, scr, F.lane);
#else
            cvt_item(ap->in[I_MWOUT], 1024, (r / 32) * 64, (r % 32) * 32, (bf16*)(ws + WS_W4T), 1024, (r % 32) * 32, nullptr, 0, scr, F.lane);
#endif
        }
        const int gt = blockIdx.x * NTHR + F.tid, ngt = F.G * NTHR;
        for (int i = gt; i < 96 * 1024 / 2; i += ngt) ((unsigned*)(ws + WS_WMIN))[416 * 1024 / 2 + i] = 0u;
        for (int i = gt; i < 2 * 64 * 1024; i += ngt) { const int l = i >> 16, n = (i >> 10) & 63, k = i & 1023; float v = 0.f;
            if (n < 32) v = ap->in[I_EXP][((size_t)l * 1024 + k) * 32 + n]; else if (n < 36) v = ap->in[I_GRP][((size_t)l * 1024 + k) * 4 + (n - 32)];
            ((bf16*)(ws + WS_WR))[i] = (bf16)(cvtpk(v, 0.f) & 0xffffu); }
        for (int i = gt; i < 2 * 1024; i += ngt) { const int dir = i >> 10, c = i & 1023; const float* p = ap->in[I_HGLB] + (size_t)dir * 3 * 1024 + c;
            const float v0 = p[0], v1 = p[1024], v2 = p[2048]; const float mx = fmaxf(v0, fmaxf(v1, v2)); const float e0 = expf(v0 - mx), e1 = expf(v1 - mx), e2 = expf(v2 - mx);
            ((float*)(ws + WS_LB))[i] = e0 / (e0 + e1 + e2); }
        for (int i = gt; i < 64 * 8; i += ngt) { const int p = i >> 3, k = i & 7; const float invf[8] = {1.0f, 0.31622776601683794f, 0.1f, 0.031622776601683794f, 0.01f, 0.0031622776601683794f, 0.001f, 0.00031622776601683794f};
            float fr = 1.0f;
#pragma unroll
            for (int q = 0; q < 8; ++q) if (q == k) fr = invf[q];
            const float ang = (float)p * fr; const float rev = ang * 0.15915494309189535f; const float fracr = rev - floorf(rev);
            ((float*)(ws + WS_ROPE))[i * 2 + 0] = __builtin_amdgcn_cosf(fracr); ((float*)(ws + WS_ROPE))[i * 2 + 1] = __builtin_amdgcn_sinf(fracr); }
    }
#if MOE_FP8
    moe_convert8(F, 0, ws + WS_MOEW0);
#else
    moe_convert(F, 0, (bf16*)(ws + WS_MOEW0));
#endif
    __syncthreads();
    if (blockIdx.x < 192) {
        const int layer = blockIdx.x / 96, col0 = (blockIdx.x % 96) * 64;
        const float* W = ap->in[I_ADAW] + (size_t)layer * D * 6144;
        int ln = F.lane; asm volatile("" : "+v"(ln));
        const int j32 = ln & 31, hh = ln >> 5, dw0 = F.wave * 128;
        LAS unsigned char* at = F.lds + F.wave * 17408;
        {
            f32x4 cv[17];
#pragma unroll
            for (int q = 0; q < 17; ++q) { const int i = ln + 64 * q, r = i >> 5, d4 = (i & 31) * 4; cv[q] = (f32x4){0.f, 0.f, 0.f, 0.f};
                if (i < 33 * 32) cv[q] = *(const f32x4*)((r < 32 ? ap->in[I_C] + r * 1024 : ap->in[I_CCTX]) + dw0 + d4); }
#pragma unroll
            for (int q = 0; q < 17; ++q) { const int i = ln + 64 * q, r = i >> 5, d4 = (i & 31) * 4;
                if (i < 33 * 32) { u32x2 w; w.x = cvtpk(silu_f(cv[q].x), silu_f(cv[q].y)); w.y = cvtpk(silu_f(cv[q].z), silu_f(cv[q].w)); *(LAS u32x2*)(at + r * 272 + d4 * 2) = w; } }
            for (int i = ln; i < 31 * 17; i += 64) { const int r = 33 + i / 17, c16 = i % 17; *(LAS u32x4*)(at + r * 272 + c16 * 16) = (u32x4){0u, 0u, 0u, 0u}; } }
        LDS_WAIT(); asm volatile("" ::: "memory");
        f32x16 acc[2][2];
#pragma unroll
        for (int rt = 0; rt < 2; ++rt)
#pragma unroll
            for (int nt = 0; nt < 2; ++nt) acc[rt][nt] = (f32x16){};
        const float* wl = W + (size_t)(dw0 + 8 * hh) * 6144 + col0 + j32;
#pragma unroll 2
        for (int ks = 0; ks < 8; ++ks) {
            float wv[2][8];
#pragma unroll
            for (int nt = 0; nt < 2; ++nt)
#pragma unroll
                for (int q = 0; q < 8; ++q) wv[nt][q] = wl[(size_t)(16 * ks + q) * 6144 + 32 * nt];
            const bf16x8 a0 = *(const LAS bf16x8*)(at + j32 * 272 + (16 * ks + 8 * hh) * 2), a1 = *(const LAS bf16x8*)(at + (32 + j32) * 272 + (16 * ks + 8 * hh) * 2);
#pragma unroll
            for (int nt = 0; nt < 2; ++nt) { u32x4 w4; w4.x = cvtpk(wv[nt][0], wv[nt][1]); w4.y = cvtpk(wv[nt][2], wv[nt][3]); w4.z = cvtpk(wv[nt][4], wv[nt][5]); w4.w = cvtpk(wv[nt][6], wv[nt][7]);
                const bf16x8 bfr = __builtin_bit_cast(bf16x8, w4);
                acc[0][nt] = __builtin_amdgcn_mfma_f32_32x32x16_bf16(a0, bfr, acc[0][nt], 0, 0, 0); acc[1][nt] = __builtin_amdgcn_mfma_f32_32x32x16_bf16(a1, bfr, acc[1][nt], 0, 0, 0); }
        }
        __syncthreads();
        LAS float* part = (LAS float*)F.lds;
#pragma unroll
        for (int nt = 0; nt < 2; ++nt) {
#pragma unroll
            for (int r = 0; r < 16; ++r) part[(F.wave * 33 + (r & 3) + 8 * (r >> 2) + 4 * hh) * 64 + 32 * nt + j32] = acc[0][nt][r];
            if (hh == 0) part[(F.wave * 33 + 32) * 64 + 32 * nt + j32] = acc[1][nt][0]; }
        __syncthreads();
        for (int i = F.tid; i < 33 * 64; i += NTHR) { const int r = i >> 6, c = i & 63; float s = ap->in[I_ADAB][(size_t)layer * 6144 + col0 + c];
#pragma unroll
            for (int w = 0; w < 8; ++w) s += part[(w * 33 + r) * 64 + c];
            ((float*)(ws + WS_MOD))[((size_t)layer * 33 + r) * 6144 + col0 + c] = s; }
    }
}

__device__ __forceinline__ void phase_ew0_generic(Frame& F) {
    KArgs ap = F.a; const float* mod = (const float*)(F.ws + WS_MOD); bf16* H = (bf16*)(F.ws + WS_H);
    for (int row0 = 2 * F.gw; row0 < T; row0 += 2 * F.ngw) {
        f32x4 v[2][4];
#pragma unroll
        for (int rr = 0; rr < 2; ++rr) { const int row = row0 + rr; const float* xr = row < TC ? ap->in[I_CTX] + (size_t)row * D : ap->in[I_X] + (size_t)(row - TC) * D;
#pragma unroll
            for (int j = 0; j < 4; ++j) v[rr][j] = *(const f32x4*)(xr + 4 * F.lane + 256 * j); }
#pragma unroll
        for (int rr = 0; rr < 2; ++rr) { const int row = row0 + rr; modulate_row(v[rr], ap->in[I_NMIX], mod + (size_t)mod_row_of(row) * 6144, 0, H + (size_t)row * D, F.lane); }
    }
}

__device__ __forceinline__ void phase_ew0(Frame& F) {
    if (T % (16 * F.G)) { phase_ew0_generic(F); return; }
    KArgs ap = F.a; const float* mod = (const float*)(F.ws + WS_MOD); bf16* H = (bf16*)(F.ws + WS_H);
    const int rpw = T / F.G, ntrip = rpw / 16, base = (int)blockIdx.x * rpw + 2 * F.wave, lc = 4 * F.lane;
    f32x4 gv[4], shv[4], scv[4]; int cur_mr = -1;
#pragma unroll
    for (int j = 0; j < 4; ++j) gv[j] = *(const f32x4*)(ap->in[I_NMIX] + lc + 256 * j);
    f32x4 dv[2][4];
#pragma unroll
    for (int rr = 0; rr < 2; ++rr) { const int row = base + rr; const float* xr = (row < TC ? ap->in[I_CTX] + (size_t)row * D : ap->in[I_X] + (size_t)(row - TC) * D) + lc;
#pragma unroll
        for (int j = 0; j < 4; ++j) dv[rr][j] = *(const f32x4*)(xr + 256 * j); }
    for (int i = 0; i < ntrip; ++i) {
        const int row0 = base + 16 * i; const int mr = mod_row_of(row0);
        if (mr != cur_mr) { cur_mr = mr;
#pragma unroll
            for (int j = 0; j < 4; ++j) { shv[j] = *(const f32x4*)(mod + (size_t)mr * 6144 + lc + 256 * j); scv[j] = *(const f32x4*)(mod + (size_t)mr * 6144 + 1024 + lc + 256 * j); } }
        f32x4 nv[2][4];
        if (i + 1 < ntrip) {
#pragma unroll
            for (int rr = 0; rr < 2; ++rr) { const int row = row0 + 16 + rr; const float* xr = (row < TC ? ap->in[I_CTX] + (size_t)row * D : ap->in[I_X] + (size_t)(row - TC) * D) + lc;
#pragma unroll
                for (int j = 0; j < 4; ++j) nv[rr][j] = *(const f32x4*)(xr + 256 * j); } }
#pragma unroll
        for (int rr = 0; rr < 2; ++rr) { const int row = row0 + rr; float ss = 0.f;
#pragma unroll
            for (int j = 0; j < 4; ++j) ss += (dv[rr][j].x * dv[rr][j].x + dv[rr][j].y * dv[rr][j].y) + (dv[rr][j].z * dv[rr][j].z + dv[rr][j].w * dv[rr][j].w);
            const float r = 1.0f / sqrtf(wave_sum(ss) * (1.0f / D) + EPS);
#pragma unroll
            for (int j = 0; j < 4; ++j) { const f32x4 y = (dv[rr][j] * r) * gv[j] * (scv[j] + 1.0f) + shv[j]; u32x2 w; w.x = cvtpk(y.x, y.y); w.y = cvtpk(y.z, y.w); *(u32x2*)(H + (size_t)row * D + lc + 256 * j) = w; } }
#pragma unroll
        for (int rr = 0; rr < 2; ++rr)
#pragma unroll
            for (int j = 0; j < 4; ++j) dv[rr][j] = nv[rr][j];
    }
}

constexpr int GL_IMG = 8704, QGP = 320, GL_G = 32 * QGP, GL_V = 2 * 32 * QGP, GL_QD = GL_V + 2 * GL_IMG, GL_KD = GL_QD + 8192, GL_EB = GL_KD + 8192, GL_O = GL_EB + 512, GL_CHAIN = GL_O + 8704;
__device__ __forceinline__ unsigned offq(unsigned row, unsigned ch) { return (unsigned)QGP * row + 16u * ch; }
__device__ __forceinline__ unsigned offt(unsigned c, unsigned q) { return 64u * c + 8u * (q ^ ((c >> 2) & 7u)); }
__device__ __forceinline__ unsigned offb(unsigned row, unsigned ch) { return 272u * row + 16u * ch; }
__device__ __forceinline__ float scan32(float v) {
#define DPP_ADD(ctrl, rmask) v += __builtin_bit_cast(float, __builtin_amdgcn_update_dpp(0, __builtin_bit_cast(int, v), ctrl, rmask, 0xf, false))
    DPP_ADD(0x111, 0xf); DPP_ADD(0x112, 0xf); DPP_ADD(0x114, 0xf); DPP_ADD(0x118, 0xf); DPP_ADD(0x142, 0xa);
#undef DPP_ADD
    return v;
}
__device__ __forceinline__ float scanmul32(float v) {
#define DPP_MUL(ctrl, rmask) v *= __builtin_bit_cast(float, __builtin_amdgcn_update_dpp(0x3f800000, __builtin_bit_cast(int, v), ctrl, rmask, 0xf, false))
    DPP_MUL(0x111, 0xf); DPP_MUL(0x112, 0xf); DPP_MUL(0x114, 0xf); DPP_MUL(0x118, 0xf); DPP_MUL(0x142, 0xa);
#undef DPP_MUL
    return v;
}
typedef short v4i16_t __attribute__((ext_vector_type(4)));
__device__ __forceinline__ u32x2 tr_read4(const LAS unsigned char* p) { return __builtin_bit_cast(u32x2, __builtin_amdgcn_ds_read_tr16_b64_v4i16((LAS v4i16_t*)p)); }
__device__ __forceinline__ int gla_row(int dir, int b, int i) {
    if (dir == 0) return (i < CTXL) ? b * CTXL + i : TC + b * SEQ + (i - CTXL);
    return (i < CTXL) ? b * CTXL + (CTXL - 1 - i) : TC + b * SEQ + (SEQ - 1 - (i - CTXL));
}
constexpr size_t A8_OFF = (size_t)160 << 20;
struct GlaOut { u32x4 oth[2], g4[2]; };
__device__ __forceinline__ void gla_fetch(GlaOut& go, const LAS unsigned char* cb, int dir, int b, int hd, int jc, int sp_r0, int sp_ch, int sgn, const bf16* P, const bf16* Other) {
    const int rel = jc < 8 ? jc : jc - 8; const bool fuse = jc < 8 ? (rel >= 4) : (rel >= 32);
    const int row0 = gla_row(dir, b, 32 * jc + sp_r0);
#pragma unroll
    for (int i = 0; i < 2; ++i) { const int row = row0 + sgn * 16 * i; const size_t off = (size_t)row * D + hd * 128 + sp_ch * 8;
        if (fuse) { go.oth[i] = *(const u32x4*)(Other + off); go.g4[i] = *(const u32x4*)(P + (size_t)row * 5120 + 4096 + hd * 128 + sp_ch * 8); } }
}
__device__ __forceinline__ void gla_finish(const GlaOut& go, const LAS unsigned char* cb, int dir, int b, int hd, int jc, int sp_r0, int sp_ch, int sgn, bf16* Mine, bf16* Aout) {
    const int rel = jc < 8 ? jc : jc - 8; const bool fuse = jc < 8 ? (rel >= 4) : (rel >= 32);
    const int row0 = gla_row(dir, b, 32 * jc + sp_r0);
#pragma unroll
    for (int i = 0; i < 2; ++i) { const int row = row0 + sgn * 16 * i; const size_t off = (size_t)row * D + hd * 128 + sp_ch * 8;
        const u32x4 mine = *(const LAS u32x4*)(cb + GL_O + (sp_r0 + 16 * i) * 272 + sp_ch * 16);
        if (!fuse) { *(u32x4*)(Mine + off) = mine; }
        else { const u32x4 oth = go.oth[i]; const u32x4 g4 = go.g4[i];
            float o[8]; float ss = 0.f;
#pragma unroll
            for (int q = 0; q < 4; ++q) { o[2 * q] = bflo(mine[q]) + bflo(oth[q]); o[2 * q + 1] = bfhi(mine[q]) + bfhi(oth[q]); ss += o[2 * q] * o[2 * q] + o[2 * q + 1] * o[2 * q + 1]; }
            ss += __shfl_xor(ss, 1); ss += __shfl_xor(ss, 2); ss += __shfl_xor(ss, 4); ss += __shfl_xor(ss, 8);
            const float r = 1.0f / sqrtf(ss * (1.0f / HGD) + EPS);
#if HG_FP8
            const float r8 = 8.0f * r;
#pragma unroll
            for (int q = 0; q < 4; ++q) { o[2 * q] = o[2 * q] * r8 * silu_f(bflo(g4[q])); o[2 * q + 1] = o[2 * q + 1] * r8 * silu_f(bfhi(g4[q])); }
            u32x2 w8; w8.x = pk4_fp8(o[0], o[1], o[2], o[3]); w8.y = pk4_fp8(o[4], o[5], o[6], o[7]);
            *(u32x2*)((unsigned char*)Aout + A8_OFF + (size_t)row * D + hd * 128 + sp_ch * 8) = w8; } }
#else
            u32x4 w;
#pragma unroll
            for (int q = 0; q < 4; ++q) w[q] = cvtpk(o[2 * q] * r * silu_f(bflo(g4[q])), o[2 * q + 1] * r * silu_f(bfhi(g4[q])));
            *(u32x4*)(Aout + off) = w; } }
#endif
}
__device__ __forceinline__ void gla_store(const LAS unsigned char* cb, int dir, int b, int hd, int jc, int sp_r0, int sp_ch, int sgn, const bf16* P, bf16* Mine, const bf16* Other, bf16* Aout) {
    GlaOut go; gla_fetch(go, cb, dir, b, hd, jc, sp_r0, sp_ch, sgn, P, Other); gla_finish(go, cb, dir, b, hd, jc, sp_r0, sp_ch, sgn, Mine, Aout);
}
__device__ __forceinline__ void phase_gla(Frame& F) {
    const bf16* P = (const bf16*)(F.ws + WS_P);
    bf16* OF = (bf16*)F.a->out; bf16* OB = (bf16*)(F.ws + WS_H);
    const int dir = F.tid >> 8, ht = F.tid & 255, lane = F.lane, hi = lane >> 5, wq = F.wave & 3; const unsigned t32_0 = lane & 31;
    LAS unsigned char* cb = F.lds + dir * GL_CHAIN;
    const int sp_ch = ht & 15, sp_r0 = ht >> 4;
    const unsigned trh = lane >> 5, trblk = (lane >> 4) & 1, trq0 = (lane & 15) >> 2, trp = lane & 3;
    const int sgn = dir ? -1 : 1;
    for (int chain = blockIdx.x; chain < NB * HGH; chain += F.G) {
        const int b = chain >> 3, hd = chain & 7;
        bf16* Out = dir ? OB : OF;
        f32x16 S[4];
#pragma unroll
        for (int c = 0; c < 4; ++c) S[c] = (f32x16){};
        u32x4 rq[2], rg[2], rv[2];
        {   const bf16* pr0 = P + (size_t)gla_row(dir, b, sp_r0) * 5120 + hd * 128 + sp_ch * 8;
#pragma unroll
            for (int i = 0; i < 2; ++i) { const bf16* pr = pr0 + (ptrdiff_t)sgn * 16 * i * 5120; rq[i] = *(const u32x4*)pr; rg[i] = *(const u32x4*)(pr + 1024 * (1 + dir)); rv[i] = *(const u32x4*)(pr + 3072); } }
#pragma unroll
        for (int i = 0; i < 2; ++i) { const unsigned o = offq(sp_r0 + 16 * i, sp_ch); *(LAS u32x4*)(cb + o) = rq[i]; *(LAS u32x4*)(cb + GL_G + o) = rg[i]; *(LAS u32x4*)(cb + GL_V + offb(sp_r0 + 16 * i, sp_ch)) = rv[i]; }
        __syncthreads();
        constexpr int NCH = KVLEN / 32;
        for (int j = 0; j < NCH; ++j) {
            const unsigned trq = trq0, t32 = t32_0;
            if (j + 1 < NCH) { const bf16* pr0 = P + (size_t)gla_row(dir, b, 32 * (j + 1) + sp_r0) * 5120 + hd * 128 + sp_ch * 8;
#pragma unroll
                for (int i = 0; i < 2; ++i) { const bf16* pr = pr0 + (ptrdiff_t)sgn * 16 * i * 5120; rq[i] = *(const u32x4*)pr; rg[i] = *(const u32x4*)(pr + 1024 * (1 + dir)); } }
            GlaOut go; if (j > 0) gla_fetch(go, cb, dir, b, hd, j - 1, sp_r0, sp_ch, sgn, P, dir ? OF : OB);
            {   unsigned ln = (unsigned)lane; asm volatile("" : "+v"(ln));
                const unsigned i16 = ln & 15u, cblk = (ln >> 4) & 1u, th = ln >> 5, c = 32u * wq + (ln & 31u);
                const unsigned bin = (unsigned)QGP * (16u * th + (i16 >> 2)) + 64u * wq + 32u * cblk + 8u * (i16 & 3u);
                float g[16], q[16], e[16];
#pragma unroll
                for (int r = 0; r < 4; ++r) { const u32x2 g2 = tr_read4(cb + GL_G + bin + QGP * 4 * r), q2 = tr_read4(cb + bin + QGP * 4 * r);
                    g[4 * r] = bflo(g2.x); g[4 * r + 1] = bfhi(g2.x); g[4 * r + 2] = bflo(g2.y); g[4 * r + 3] = bfhi(g2.y); q[4 * r] = bflo(q2.x); q[4 * r + 1] = bfhi(q2.x); q[4 * r + 2] = bflo(q2.y); q[4 * r + 3] = bfhi(q2.y); }
                e[0] = g[0];
#pragma unroll
                for (int i = 1; i < 16; ++i) e[i] = e[i - 1] * g[i];
                const float tot = __shfl_xor(e[15], 32); const float mh = th ? tot : 1.0f;
#pragma unroll
                for (int i = 0; i < 16; ++i) e[i] *= mh;
#pragma unroll
                for (int r = 0; r < 4; ++r) { float qd[4], kd[4];
#pragma unroll
                    for (int i = 0; i < 4; ++i) { const float ei = fast_rcp(e[4 * r + i]); const float kk = 1.0f - g[4 * r + i]; qd[i] = q[4 * r + i] * e[4 * r + i]; kd[i] = kk * ei; }
                    u32x2 wqd, wkd; wqd.x = cvtpk(qd[0], qd[1]); wqd.y = cvtpk(qd[2], qd[3]); wkd.x = cvtpk(kd[0], kd[1]); wkd.y = cvtpk(kd[2], kd[3]);
                    const unsigned o = offt(c, 4u * th + r); *(LAS u32x2*)(cb + GL_QD + o) = wqd; *(LAS u32x2*)(cb + GL_KD + o) = wkd; }
                if (th) *(LAS float*)(cb + GL_EB + c * 4u) = e[15]; }
            if (j > 0) gla_finish(go, cb, dir, b, hd, j - 1, sp_r0, sp_ch, sgn, Out, OF);
            __syncthreads();
            if (j + 1 < NCH) {
                const bf16* pv0 = P + (size_t)gla_row(dir, b, 32 * (j + 1) + sp_r0) * 5120 + hd * 128 + sp_ch * 8 + 3072;
#pragma unroll
                for (int i = 0; i < 2; ++i) rv[i] = *(const u32x4*)(pv0 + (ptrdiff_t)sgn * 16 * i * 5120);
            }
            bf16x8 qd[8];
            f32x16 X = (f32x16){};
            unsigned xb[4];
            { const unsigned i16 = t32 & 15u, blk = t32 >> 4, qh = (4u * blk + (i16 & 3u)) ^ (unsigned)hi;
#pragma unroll
              for (int K = 0; K < 4; ++K) xb[K] = ((i16 >> 2) + 4u * hi) * 64u + ((qh ^ (2u * K)) * 8u); }
#pragma unroll
            for (int ks = 0; ks < 8; ++ks) { const unsigned o0 = xb[2 * (ks & 1)] + (16 * ks) * 64, o1 = xb[2 * (ks & 1) + 1] + (16 * ks + 8) * 64;
                const u32x2 a0 = tr_read4(cb + GL_QD + o0), a1 = tr_read4(cb + GL_QD + o1), k0 = tr_read4(cb + GL_KD + o0), k1 = tr_read4(cb + GL_KD + o1);
                qd[ks] = __builtin_bit_cast(bf16x8, (u32x4){a0.x, a0.y, a1.x, a1.y}); const bf16x8 kdf = __builtin_bit_cast(bf16x8, (u32x4){k0.x, k0.y, k1.x, k1.y});
                X = __builtin_amdgcn_mfma_f32_32x32x16_bf16(kdf, qd[ks], X, 0, 0, 0);
                if ((ks & 3) == 3) __builtin_amdgcn_sched_barrier(0); }
#pragma unroll
            for (int r = 0; r < 16; ++r) { const int sr = (r & 3) + 8 * (r >> 2) + 4 * hi; X[r] = (sr <= (int)t32) ? X[r] : 0.f; }
            bf16x8 xa[2];
            { u32x4 w; w.x = cvtpk(X[0], X[1]); w.y = cvtpk(X[2], X[3]); w.z = cvtpk(X[4], X[5]); w.w = cvtpk(X[6], X[7]); xa[0] = __builtin_bit_cast(bf16x8, w);
              w.x = cvtpk(X[8], X[9]); w.y = cvtpk(X[10], X[11]); w.z = cvtpk(X[12], X[13]); w.w = cvtpk(X[14], X[15]); xa[1] = __builtin_bit_cast(bf16x8, w); }
            const LAS unsigned char* vbase = cb + GL_V + (j & 1) * GL_IMG;
            bf16x8 vb[2];
#pragma unroll
            for (int kk = 0; kk < 2; ++kk) { const u32x2 p0 = tr_read4(vbase + offb(16 * kk + 0 + 4 * trh + trq, 4 * wq + 2 * trblk + (trp >> 1)) + 8 * (trp & 1)), p1 = tr_read4(vbase + offb(16 * kk + 8 + 4 * trh + trq, 4 * wq + 2 * trblk + (trp >> 1)) + 8 * (trp & 1));
                vb[kk] = __builtin_bit_cast(bf16x8, (u32x4){p0.x, p0.y, p1.x, p1.y}); }
            f32x16 O = (f32x16){};
            O = __builtin_amdgcn_mfma_f32_32x32x16_bf16(vb[0], xa[0], O, 0, 0, 0); O = __builtin_amdgcn_mfma_f32_32x32x16_bf16(vb[1], xa[1], O, 0, 0, 0);
#pragma unroll
            for (int ct = 0; ct < 4; ++ct)
#pragma unroll
                for (int kk = 0; kk < 2; ++kk) { u32x4 w; w.x = cvtpk(S[ct][8 * kk], S[ct][8 * kk + 1]); w.y = cvtpk(S[ct][8 * kk + 2], S[ct][8 * kk + 3]); w.z = cvtpk(S[ct][8 * kk + 4], S[ct][8 * kk + 5]); w.w = cvtpk(S[ct][8 * kk + 6], S[ct][8 * kk + 7]);
                    O = __builtin_amdgcn_mfma_f32_32x32x16_bf16(__builtin_bit_cast(bf16x8, w), qd[2 * ct + kk], O, 0, 0, 0); }
            unsigned sb[4];
            { const unsigned fh = ((t32 >> 2) & 7u) ^ (unsigned)hi;
#pragma unroll
              for (int K = 0; K < 4; ++K) sb[K] = t32 * 64u + ((fh ^ (2u * K)) * 8u); }
#pragma unroll
            for (int ct = 0; ct < 4; ++ct) {
#pragma unroll
                for (int kk = 0; kk < 2; ++kk) { const u32x2 p0 = *(const LAS u32x2*)(cb + GL_KD + sb[2 * kk] + 32 * ct * 64), p1 = *(const LAS u32x2*)(cb + GL_KD + sb[2 * kk + 1] + 32 * ct * 64);
                    S[ct] = __builtin_amdgcn_mfma_f32_32x32x16_bf16(__builtin_bit_cast(bf16x8, (u32x4){p0.x, p0.y, p1.x, p1.y}), vb[kk], S[ct], 0, 0, 0); }
#pragma unroll
                for (int g = 0; g < 4; ++g) { const f32x4 eb = *(const LAS f32x4*)(cb + GL_EB + (32 * ct + 8 * g + 4 * hi) * 4);
                    S[ct][4 * g] *= eb.x; S[ct][4 * g + 1] *= eb.y; S[ct][4 * g + 2] *= eb.z; S[ct][4 * g + 3] *= eb.w; }
            }
#pragma unroll
            for (int g = 0; g < 4; ++g) { u32x2 w; w.x = cvtpk(O[4 * g], O[4 * g + 1]); w.y = cvtpk(O[4 * g + 2], O[4 * g + 3]);
                *(LAS u32x2*)(cb + GL_O + t32 * 272 + (32 * wq + 8 * g + 4 * hi) * 2) = w; }
            if (j + 1 < NCH) {
#pragma unroll
                for (int i = 0; i < 2; ++i) { *(LAS u32x4*)(cb + GL_V + ((j + 1) & 1) * GL_IMG + offb(sp_r0 + 16 * i, sp_ch)) = rv[i];
                    const unsigned o = offq(sp_r0 + 16 * i, sp_ch); *(LAS u32x4*)(cb + o) = rq[i]; *(LAS u32x4*)(cb + GL_G + o) = rg[i]; }
            }
            asm volatile("s_waitcnt vmcnt(0)" ::: "memory");
            __syncthreads();
        }
        gla_store(cb, dir, b, hd, NCH - 1, sp_r0, sp_ch, sgn, P, Out, dir ? OF : OB, OF);
        __syncthreads();
    }
}

__device__ __forceinline__ void phase_ew1(Frame& F) {
    const bf16* P = (const bf16*)(F.ws + WS_P); bf16* OF = (bf16*)F.a->out; const bf16* OB = (const bf16*)(F.ws + WS_H);
    for (int row = F.gw; row < T; row += F.ngw) {
#pragma unroll
        for (int j = 0; j < 4; ++j) { const int col = 4 * F.lane + 256 * j;
            const u32x2 a2 = *(const u32x2*)(OF + (size_t)row * D + col), b2 = *(const u32x2*)(OB + (size_t)row * D + col), g2 = *(const u32x2*)(P + (size_t)row * 5120 + 4096 + col);
            float o[4] = {bflo(a2.x) + bflo(b2.x), bfhi(a2.x) + bfhi(b2.x), bflo(a2.y) + bflo(b2.y), bfhi(a2.y) + bfhi(b2.y)};
            float ss = (o[0] * o[0] + o[1] * o[1]) + (o[2] * o[2] + o[3] * o[3]);
            ss = half_sum(ss);
            const float r = 1.0f / sqrtf(ss * (1.0f / HGD) + EPS);
            u32x2 w; w.x = cvtpk(o[0] * r * bflo(g2.x), o[1] * r * bfhi(g2.x)); w.y = cvtpk(o[2] * r * bflo(g2.y), o[3] * r * bfhi(g2.y));
            *(u32x2*)(OF + (size_t)row * D + col) = w; }
    }
}

__device__ __forceinline__ void phase_ew2_generic(Frame& F, int layer, const bf16* X, int row_lo, int xrow_off, unsigned char* H8) {
    KArgs ap = F.a; const float* mod = (const float*)(F.ws + WS_MOD) + (size_t)layer * 33 * 6144; bf16* H = (bf16*)(F.ws + WS_H);
    for (int row0 = row_lo + 2 * F.gw; row0 < T; row0 += 2 * F.ngw) {
        u32x2 xw[2][4];
#pragma unroll
        for (int rr = 0; rr < 2; ++rr) { const bf16* xr = X + (size_t)(row0 + rr - xrow_off) * D;
#pragma unroll
            for (int j = 0; j < 4; ++j) xw[rr][j] = *(const u32x2*)(xr + 4 * F.lane + 256 * j); }
#pragma unroll
        for (int rr = 0; rr < 2; ++rr) { const int row = row0 + rr; f32x4 v[4];
#pragma unroll
            for (int j = 0; j < 4; ++j) v[j] = (f32x4){bflo(xw[rr][j].x), bfhi(xw[rr][j].x), bflo(xw[rr][j].y), bfhi(xw[rr][j].y)};
            const float r = modulate_row(v, ap->in[I_NFFN] + (size_t)layer * D, mod + (size_t)mod_row_of(row) * 6144, 3, H8 ? nullptr : H + (size_t)row * D, F.lane, H8 ? H8 + (size_t)row * D : nullptr);
            if (F.lane == 0) ((float*)(F.ws + WS_RMS))[row] = r; }
    }
}

__device__ __forceinline__ void phase_ew2(Frame& F, int layer, const bf16* X, int row_lo, int xrow_off, unsigned char* H8) {
    if (!H8 || ((T - row_lo) % (16 * F.G))) { phase_ew2_generic(F, layer, X, row_lo, xrow_off, H8); return; }
    KArgs ap = F.a; const float* mod = (const float*)(F.ws + WS_MOD) + (size_t)layer * 33 * 6144; float* rms = (float*)(F.ws + WS_RMS);
    const int rpw = (T - row_lo) / F.G, ntrip = rpw / 16, base = row_lo + (int)blockIdx.x * rpw + 2 * F.wave, lc = 4 * F.lane;
    f32x4 gv[4], shv[4], scv[4]; int cur_mr = -1;
#pragma unroll
    for (int j = 0; j < 4; ++j) gv[j] = *(const f32x4*)(ap->in[I_NFFN] + (size_t)layer * D + lc + 256 * j);
    u32x2 dv[2][4];
#pragma unroll
    for (int rr = 0; rr < 2; ++rr) { const bf16* xr = X + (size_t)(base + rr - xrow_off) * D + lc;
#pragma unroll
        for (int j = 0; j < 4; ++j) dv[rr][j] = *(const u32x2*)(xr + 256 * j); }
    for (int i = 0; i < ntrip; ++i) {
        const int row0 = base + 16 * i; const int mr = mod_row_of(row0);
        if (mr != cur_mr) { cur_mr = mr;
#pragma unroll
            for (int j = 0; j < 4; ++j) { shv[j] = *(const f32x4*)(mod + (size_t)mr * 6144 + 3 * 1024 + lc + 256 * j); scv[j] = *(const f32x4*)(mod + (size_t)mr * 6144 + 4 * 1024 + lc + 256 * j); } }
        u32x2 nv[2][4];
        if (i + 1 < ntrip) {
#pragma unroll
            for (int rr = 0; rr < 2; ++rr) { const bf16* xr = X + (size_t)(row0 + 16 + rr - xrow_off) * D + lc;
#pragma unroll
                for (int j = 0; j < 4; ++j) nv[rr][j] = *(const u32x2*)(xr + 256 * j); } }
#pragma unroll
        for (int rr = 0; rr < 2; ++rr) { const int row = row0 + rr; f32x4 v[4]; float ss = 0.f;
#pragma unroll
            for (int j = 0; j < 4; ++j) { v[j] = (f32x4){bflo(dv[rr][j].x), bfhi(dv[rr][j].x), bflo(dv[rr][j].y), bfhi(dv[rr][j].y)}; ss += (v[j].x * v[j].x + v[j].y * v[j].y) + (v[j].z * v[j].z + v[j].w * v[j].w); }
            const float r = 1.0f / sqrtf(wave_sum(ss) * (1.0f / D) + EPS);
#pragma unroll
            for (int j = 0; j < 4; ++j) { const f32x4 y = (v[j] * r) * gv[j] * (scv[j] + 1.0f) + shv[j]; *(unsigned*)(H8 + (size_t)row * D + lc + 256 * j) = pk4_fp8(y.x, y.y, y.z, y.w); }
            if (F.lane == 0) rms[row] = r; }
#pragma unroll
        for (int rr = 0; rr < 2; ++rr)
#pragma unroll
            for (int j = 0; j < 4; ++j) dv[rr][j] = nv[rr][j];
    }
}

__device__ __forceinline__ void phase_router_tables(Frame& F) {
    KArgs ap = F.a; const float* mod = (const float*)(F.ws + WS_MOD); const bf16* WrT = (const bf16*)(F.ws + WS_WR); bf16* WP = (bf16*)(F.ws + WS_WRP); float* CB = (float*)(F.ws + WS_CB);
    const int gt = blockIdx.x * NTHR + F.tid, ngt = F.G * NTHR;
    for (int i0 = gt; i0 < 2 * 33 * 64 * 256; i0 += 4 * ngt) {
        u32x2 w2[4]; f32x4 g4[4], sc[4];
#pragma unroll
        for (int q = 0; q < 4; ++q) { const int i4 = i0 + q * ngt; if (i4 < 2 * 33 * 64 * 256) { const int k = (i4 & 255) * 4, n = (i4 >> 8) & 63, lb = i4 >> 14, l = lb / 33;
            w2[q] = *(const u32x2*)(WrT + ((size_t)l * 64 + n) * 1024 + k); g4[q] = *(const f32x4*)(ap->in[I_NFFN] + (size_t)l * D + k); sc[q] = *(const f32x4*)(mod + (size_t)lb * 6144 + 4 * 1024 + k); } }
#pragma unroll
        for (int q = 0; q < 4; ++q) { const int i4 = i0 + q * ngt; if (i4 < 2 * 33 * 64 * 256) { const int k = (i4 & 255) * 4, n = (i4 >> 8) & 63, lb = i4 >> 14;
            u32x2 o; o.x = cvtpk(bflo(w2[q].x) * g4[q].x * (sc[q].x + 1.0f), bfhi(w2[q].x) * g4[q].y * (sc[q].y + 1.0f)); o.y = cvtpk(bflo(w2[q].y) * g4[q].z * (sc[q].z + 1.0f), bfhi(w2[q].y) * g4[q].w * (sc[q].w + 1.0f));
            *(u32x2*)(WP + ((size_t)lb * 64 + n) * 1024 + k) = o; } } }
    for (int task = F.gw; task < 2 * 33 * 64; task += F.ngw) { const int n = task & 63, lb = task >> 6, l = lb / 33; float sacc = 0.f;
        if (n < 36) {
#pragma unroll
            for (int j = 0; j < 4; ++j) { const int k = 4 * F.lane + 256 * j; const u32x2 w2 = *(const u32x2*)(WrT + ((size_t)l * 64 + n) * 1024 + k); const f32x4 sh = *(const f32x4*)(mod + (size_t)lb * 6144 + 3 * 1024 + k);
                sacc += (bflo(w2.x) * sh.x + bfhi(w2.x) * sh.y) + (bflo(w2.y) * sh.z + bfhi(w2.y) * sh.w); }
            sacc = wave_sum(sacc); }
        if (F.lane == 0) CB[task] = sacc; }
}

__device__ __forceinline__ void phase_router(Frame& F, int layer, int tok0, int tpw, const bf16* X, int xrow_off) {
    const bf16* WP = (const bf16*)(F.ws + WS_WRP) + (size_t)layer * 33 * 64 * 1024; const float* CB = (const float*)(F.ws + WS_CB) + layer * 33 * 64; const float* rms = (const float*)(F.ws + WS_RMS);
    int* eid = (int*)(F.ws + WS_EID); float* gwt = (float*)(F.ws + WS_GW); int* cnt = (int*)(F.ws + WS_CNT);
    constexpr int WPITCH = 2064;
    LAS int* lcnt = (LAS int*)(F.lds + 64 * WPITCH);
    if (F.tid < 32) lcnt[F.tid] = 0;
    const int mb0 = mod_row_of(tok0 + (int)blockIdx.x * tpw);
    for (int i = F.tid; i < 64 * 128; i += NTHR) { const int row = i >> 7, ch = i & 127; *(LAS u32x4*)(F.lds + row * WPITCH + ch * 16) = *(const u32x4*)(WP + ((size_t)mb0 * 64 + row) * 1024 + ch * 8); }
    __syncthreads();
    const int ntask = tpw / 32; const int r32 = F.lane & 31, hh = F.lane >> 5;
    for (int task = F.wave; task < ntask; task += NWAVES) {
        const int tokb = tok0 + blockIdx.x * tpw + task * 32, tok = tokb + r32, mb = mod_row_of(tokb);
        const bf16* WrT = WP + (size_t)mb * 64 * 1024; const float* cb = CB + mb * 64;
        const bf16* hrow = X + (size_t)(tok - xrow_off) * D + 8 * hh; const bf16* w0 = WrT + (size_t)r32 * D + 8 * hh; const bf16* w1 = WrT + (size_t)(32 + r32) * D + 8 * hh;
        f32x16 acc0 = {}, acc1 = {};
        if (mb == mb0) {
            const LAS unsigned char* l0 = F.lds + r32 * WPITCH + 16 * hh; const LAS unsigned char* l1 = l0 + 32 * WPITCH;
#pragma unroll 8
            for (int ks = 0; ks < 64; ++ks) { const bf16x8 bfr = *(const bf16x8*)(hrow + 16 * ks), a0 = *(const LAS bf16x8*)(l0 + 32 * ks), a1 = *(const LAS bf16x8*)(l1 + 32 * ks);
                acc0 = __builtin_amdgcn_mfma_f32_32x32x16_bf16(a0, bfr, acc0, 0, 0, 0); acc1 = __builtin_amdgcn_mfma_f32_32x32x16_bf16(a1, bfr, acc1, 0, 0, 0); }
        } else {
#pragma unroll 4
            for (int ks = 0; ks < 64; ++ks) { const bf16x8 bfr = *(const bf16x8*)(hrow + 16 * ks), a0 = *(const bf16x8*)(w0 + 16 * ks), a1 = *(const bf16x8*)(w1 + 16 * ks);
                acc0 = __builtin_amdgcn_mfma_f32_32x32x16_bf16(a0, bfr, acc0, 0, 0, 0); acc1 = __builtin_amdgcn_mfma_f32_32x32x16_bf16(a1, bfr, acc1, 0, 0, 0); }
        }
        { const float rt = __builtin_bit_cast(float, __hip_atomic_load((const unsigned*)(rms + tok), __ATOMIC_RELAXED, __HIP_MEMORY_SCOPE_AGENT));
#pragma unroll
          for (int g = 0; g < 4; ++g) { const f32x4 c4 = *(const f32x4*)(cb + 8 * g + 4 * hh); acc0[4 * g] = acc0[4 * g] * rt + c4.x; acc0[4 * g + 1] = acc0[4 * g + 1] * rt + c4.y; acc0[4 * g + 2] = acc0[4 * g + 2] * rt + c4.z; acc0[4 * g + 3] = acc0[4 * g + 3] * rt + c4.w; }
          const f32x4 c4 = *(const f32x4*)(cb + 32 + 4 * hh); acc1[0] = acc1[0] * rt + c4.x; acc1[1] = acc1[1] * rt + c4.y; acc1[2] = acc1[2] * rt + c4.z; acc1[3] = acc1[3] * rt + c4.w; }
        int gs = 0; float gm = acc1[0];
        if (acc1[1] > gm) { gm = acc1[1]; gs = 1; } if (acc1[2] > gm) { gm = acc1[2]; gs = 2; } if (acc1[3] > gm) { gm = acc1[3]; gs = 3; }
        float pg = 1.0f / (expf(acc1[0] - gm) + expf(acc1[1] - gm) + expf(acc1[2] - gm) + expf(acc1[3] - gm));
        gs = __shfl(gs, r32); pg = __shfl(pg, r32);
        float v[4];
#pragma unroll
        for (int i = 0; i < 4; ++i) v[i] = gs == 0 ? acc0[i] : gs == 1 ? acc0[4 + i] : gs == 2 ? acc0[8 + i] : acc0[12 + i];
        float ta = v[0], tb = -INFINITY; int ia = 0, ib = -1;
#pragma unroll
        for (int i = 1; i < 4; ++i) { if (v[i] > ta) { tb = ta; ib = ia; ta = v[i]; ia = i; } else if (v[i] > tb) { tb = v[i]; ib = i; } }
        ia += 4 * hh; ib += 4 * hh;
        const float pa = __shfl_xor(ta, 32), pb = __shfl_xor(tb, 32); const int pia = __shfl_xor(ia, 32), pib = __shfl_xor(ib, 32);
        float l1, l2; int i1, i2;
#define BETTER(x, ix, y, iy) ((x) > (y) || ((x) == (y) && (ix) < (iy)))
        if (BETTER(ta, ia, pa, pia)) { l1 = ta; i1 = ia; if (BETTER(tb, ib, pa, pia)) { l2 = tb; i2 = ib; } else { l2 = pa; i2 = pia; } }
        else { l1 = pa; i1 = pia; if (BETTER(ta, ia, pb, pib)) { l2 = ta; i2 = ia; } else { l2 = pb; i2 = pib; } }
#undef BETTER
        const float w1g = pg / (1.0f + expf(l2 - l1)), w2g = pg - w1g;
        if (hh == 0) { const int e1 = gs * 8 + i1, e2 = gs * 8 + i2;
            eid[2 * tok] = e1; eid[2 * tok + 1] = e2; gwt[2 * tok] = w1g; gwt[2 * tok + 1] = w2g;
            atomicAdd((int*)(lcnt + e1), 1); atomicAdd((int*)(lcnt + e2), 1); }
    }
    __syncthreads();
    if (F.tid < 32) cnt[blockIdx.x * 32 + F.tid] = lcnt[F.tid];
}

__device__ __forceinline__ void phase_assign(Frame& F, int tok0, int tpw) {
    const int* eid = (const int*)(F.ws + WS_EID); const float* gwt = (const float*)(F.ws + WS_GW); const int* cnt = (const int*)(F.ws + WS_CNT);
    int* slot = (int*)(F.ws + WS_SLOT); int* tokrow = (int*)(F.ws + WS_TOKROW); float* wrow = (float*)(F.ws + WS_WROW); int* meta = (int*)(F.ws + WS_META); int* blke = (int*)(F.ws + WS_BLKE);
    LAS int* tot = (LAS int*)F.lds, *mybase = tot + 32, *pstart = tot + 64  , *wtot = tot + 128  , *ptot = tot + 512  , *pbel = tot + 1024  ;
    {
        const int e = F.tid & 31, part = F.tid >> 5, per = (F.G + 15) / 16; int s = 0, mb = 0;
#pragma unroll 8
        for (int q = 0; q < per; ++q) { const int w = part * per + q; if (w < F.G) { const int c = cnt[w * 32 + e]; s += c; if (w < (int)blockIdx.x) mb += c; } }
        ptot[part * 32 + e] = s; pbel[part * 32 + e] = mb; }
    __syncthreads();
    if (F.tid < 32) { int s = 0, mb = 0;
#pragma unroll
        for (int q = 0; q < 16; ++q) { s += ptot[q * 32 + F.tid]; mb += pbel[q * 32 + F.tid]; }
        tot[F.tid] = s; mybase[F.tid] = mb; }
    __syncthreads();
    if (F.tid == 0) { int p = 0; for (int e = 0; e < 32; ++e) { pstart[e] = p; p += ((tot[e] + 255) >> 8) << 8; } pstart[32] = p; }
    __syncthreads();
    int e1 = -1, e2 = -1, tok = 0;
    if (F.tid < tpw) { tok = tok0 + blockIdx.x * tpw + F.tid; e1 = eid[2 * tok]; e2 = eid[2 * tok + 1]; }
    int r1 = 0, r2 = 0; const unsigned long long lt = (F.lane == 0) ? 0ull : (~0ull >> (64 - F.lane));
    for (int e = 0; e < 32; ++e) { const unsigned long long m1 = __ballot(e1 == e), m2 = __ballot(e2 == e); const int below = __popcll(m1 & lt) + __popcll(m2 & lt);
        if (e1 == e) r1 = below; if (e2 == e) r2 = below; if (F.lane == 0) wtot[F.wave * 32 + e] = __popcll(m1) + __popcll(m2); }
    __syncthreads();
    if (F.tid < tpw) {
        int o1 = 0, o2 = 0; for (int w = 0; w < F.wave; ++w) { o1 += wtot[w * 32 + e1]; o2 += wtot[w * 32 + e2]; }
        const int row1 = pstart[e1] + mybase[e1] + o1 + r1, row2 = pstart[e2] + mybase[e2] + o2 + r2;
        tokrow[row1] = tok; tokrow[row2] = tok; wrow[row1] = gwt[2 * tok]; wrow[row2] = gwt[2 * tok + 1]; slot[2 * tok] = row1; slot[2 * tok + 1] = row2;
    }
    if (blockIdx.x < 32) { const int e = blockIdx.x; for (int r = pstart[e] + tot[e] + F.tid; r < pstart[e + 1]; r += NTHR) { tokrow[r] = tok0; wrow[r] = 0.f; } }
    if (blockIdx.x == 0) { const int nblk = pstart[32] >> 8; if (F.tid == 0) meta[0] = nblk;
        for (int bk = F.tid; bk < nblk; bk += NTHR) { int e = 0; for (int q = 1; q < 32; ++q) if (bk * 256 >= pstart[q]) e = q; blke[bk] = e; } }
}

template <bool FINAL>
__device__ __forceinline__ void phase_combine_generic(Frame& F, int layer, const bf16* X, int xrow_off, int row_lo, const bf16* Y, bf16* out16, float* out32) {
    KArgs ap = F.a; const float* modl = (const float*)(F.ws + WS_MOD) + (size_t)layer * 33 * 6144; const int* slot = (const int*)(F.ws + WS_SLOT); bf16* H = (bf16*)(F.ws + WS_H);
    for (int row0 = row_lo + 2 * F.gw; row0 < T; row0 += 2 * F.ngw) {
        u32x2 xw[2][4], p0[2][4], p1[2][4];
#pragma unroll
        for (int rr = 0; rr < 2; ++rr) { const int row = row0 + rr; const bf16* xr = X + (size_t)(row - xrow_off) * D;
            const bf16* y0 = Y + (size_t)slot[2 * row] * D; const bf16* y1 = Y + (size_t)slot[2 * row + 1] * D;
#pragma unroll
            for (int j = 0; j < 4; ++j) { const int col = 4 * F.lane + 256 * j; xw[rr][j] = *(const u32x2*)(xr + col); p0[rr][j] = *(const u32x2*)(y0 + col); p1[rr][j] = *(const u32x2*)(y1 + col); } }
#pragma unroll
        for (int rr = 0; rr < 2; ++rr) { const int row = row0 + rr; const float* mr = modl + (size_t)mod_row_of(row) * 6144;
            f32x4 v[4];
#pragma unroll
            for (int j = 0; j < 4; ++j) { const int col = 4 * F.lane + 256 * j; const f32x4 gt = *(const f32x4*)(mr + 5 * 1024 + col);
                const f32x4 x = (f32x4){bflo(xw[rr][j].x), bfhi(xw[rr][j].x), bflo(xw[rr][j].y), bfhi(xw[rr][j].y)};
                f32x4 f; f.x = bflo(p0[rr][j].x) + bflo(p1[rr][j].x); f.y = bfhi(p0[rr][j].x) + bfhi(p1[rr][j].x); f.z = bflo(p0[rr][j].y) + bflo(p1[rr][j].y); f.w = bfhi(p0[rr][j].y) + bfhi(p1[rr][j].y);
                v[j] = x + gt * f;
                if (row >= TC) { if (FINAL) *(f32x4*)(out32 + (size_t)(row - TC) * D + col) = v[j];
                                 else { u32x2 w; w.x = cvtpk(v[j].x, v[j].y); w.y = cvtpk(v[j].z, v[j].w); *(u32x2*)(out16 + (size_t)(row - TC) * D + col) = w; } } }
            if (!FINAL) modulate_row(v, ap->in[I_NMIX] + (size_t)(layer + 1) * D, (const float*)(F.ws + WS_MOD) + (size_t)(layer + 1) * 33 * 6144 + (size_t)mod_row_of(row) * 6144, 0, H + (size_t)row * D, F.lane); }
    }
}

template <bool FINAL>
__device__ __forceinline__ void phase_combine(Frame& F, int layer, const bf16* X, int xrow_off, int row_lo, const bf16* Y, bf16* out16, float* out32) {
    if ((T - row_lo) % (16 * F.G)) { phase_combine_generic<FINAL>(F, layer, X, xrow_off, row_lo, Y, out16, out32); return; }
    KArgs ap = F.a; const float* modl = (const float*)(F.ws + WS_MOD) + (size_t)layer * 33 * 6144; const float* modn = (const float*)(F.ws + WS_MOD) + (size_t)(layer + 1) * 33 * 6144;
    const int* slot = (const int*)(F.ws + WS_SLOT); bf16* H = (bf16*)(F.ws + WS_H);
    const int rpw = (T - row_lo) / F.G, ntrip = rpw / 16, base = row_lo + (int)blockIdx.x * rpw + 2 * F.wave, lc = 4 * F.lane;
    f32x4 gtv[4], shv[4], scv[4], gv[4]; int cur_mr = -1;
    if (!FINAL) {
#pragma unroll
        for (int j = 0; j < 4; ++j) gv[j] = *(const f32x4*)(ap->in[I_NMIX] + (size_t)(layer + 1) * D + lc + 256 * j); }
    int sl[2][2];
#pragma unroll
    for (int rr = 0; rr < 2; ++rr) { sl[rr][0] = slot[2 * (base + rr)]; sl[rr][1] = slot[2 * (base + rr) + 1]; }
    u32x2 dx[2][4], d0[2][4], d1[2][4];
#pragma unroll
    for (int rr = 0; rr < 2; ++rr) { const bf16* xr = X + (size_t)(base + rr - xrow_off) * D + lc; const bf16* y0 = Y + (size_t)sl[rr][0] * D + lc; const bf16* y1 = Y + (size_t)sl[rr][1] * D + lc;
#pragma unroll
        for (int j = 0; j < 4; ++j) { dx[rr][j] = *(const u32x2*)(xr + 256 * j); d0[rr][j] = *(const u32x2*)(y0 + 256 * j); d1[rr][j] = *(const u32x2*)(y1 + 256 * j); } }
    if (ntrip > 1) {
#pragma unroll
        for (int rr = 0; rr < 2; ++rr) { sl[rr][0] = slot[2 * (base + 16 + rr)]; sl[rr][1] = slot[2 * (base + 16 + rr) + 1]; } }
    for (int i = 0; i < ntrip; ++i) {
        const int row0 = base + 16 * i; const int mr = mod_row_of(row0);
        if (mr != cur_mr) { cur_mr = mr;
#pragma unroll
            for (int j = 0; j < 4; ++j) { gtv[j] = *(const f32x4*)(modl + (size_t)mr * 6144 + 5 * 1024 + lc + 256 * j);
                if (!FINAL) { shv[j] = *(const f32x4*)(modn + (size_t)mr * 6144 + lc + 256 * j); scv[j] = *(const f32x4*)(modn + (size_t)mr * 6144 + 1024 + lc + 256 * j); } } }
        u32x2 nx[2][4], n0[2][4], n1[2][4]; int sn[2][2];
        if (i + 1 < ntrip) {
#pragma unroll
            for (int rr = 0; rr < 2; ++rr) { const bf16* xr = X + (size_t)(row0 + 16 + rr - xrow_off) * D + lc; const bf16* y0 = Y + (size_t)sl[rr][0] * D + lc; const bf16* y1 = Y + (size_t)sl[rr][1] * D + lc;
#pragma unroll
                for (int j = 0; j < 4; ++j) { nx[rr][j] = *(const u32x2*)(xr + 256 * j); n0[rr][j] = *(const u32x2*)(y0 + 256 * j); n1[rr][j] = *(const u32x2*)(y1 + 256 * j); } } }
        if (i + 2 < ntrip) {
#pragma unroll
            for (int rr = 0; rr < 2; ++rr) { sn[rr][0] = slot[2 * (row0 + 32 + rr)]; sn[rr][1] = slot[2 * (row0 + 32 + rr) + 1]; } }
#pragma unroll
        for (int rr = 0; rr < 2; ++rr) { const int row = row0 + rr; f32x4 v[4]; float ss = 0.f;
#pragma unroll
            for (int j = 0; j < 4; ++j) { const int col = lc + 256 * j;
                const f32x4 x = (f32x4){bflo(dx[rr][j].x), bfhi(dx[rr][j].x), bflo(dx[rr][j].y), bfhi(dx[rr][j].y)};
                f32x4 f; f.x = bflo(d0[rr][j].x) + bflo(d1[rr][j].x); f.y = bfhi(d0[rr][j].x) + bfhi(d1[rr][j].x); f.z = bflo(d0[rr][j].y) + bflo(d1[rr][j].y); f.w = bfhi(d0[rr][j].y) + bfhi(d1[rr][j].y);
                v[j] = x + gtv[j] * f;
                ss += (v[j].x * v[j].x + v[j].y * v[j].y) + (v[j].z * v[j].z + v[j].w * v[j].w);
                if (row >= TC) { if (FINAL) *(f32x4*)(out32 + (size_t)(row - TC) * D + col) = v[j];
                                 else { u32x2 w; w.x = cvtpk(v[j].x, v[j].y); w.y = cvtpk(v[j].z, v[j].w); *(u32x2*)(out16 + (size_t)(row - TC) * D + col) = w; } } }
            if (!FINAL) { const float r = 1.0f / sqrtf(wave_sum(ss) * (1.0f / D) + EPS);
#pragma unroll
                for (int j = 0; j < 4; ++j) { const f32x4 y = (v[j] * r) * gv[j] * (scv[j] + 1.0f) + shv[j]; u32x2 w; w.x = cvtpk(y.x, y.y); w.y = cvtpk(y.z, y.w); *(u32x2*)(H + (size_t)row * D + lc + 256 * j) = w; } } }
#pragma unroll
        for (int rr = 0; rr < 2; ++rr) { sl[rr][0] = sn[rr][0]; sl[rr][1] = sn[rr][1];
#pragma unroll
            for (int j = 0; j < 4; ++j) { dx[rr][j] = nx[rr][j]; d0[rr][j] = n0[rr][j]; d1[rr][j] = n1[rr][j]; } }
    }
}

__device__ __forceinline__ void phase_cstats(Frame& F) {
    const bf16* C = (const bf16*)(F.ws + WS_C); float* rq = (float*)(F.ws + WS_RQ); float* rkv = (float*)(F.ws + WS_RKV);
    const int hl = F.lane & 31, hh = F.lane >> 5;
    for (int row = 2 * F.gw + hh; row < T; row += 2 * F.ngw) {
        const u32x4 q = *(const u32x4*)(C + (size_t)row * 512 + 8 * hl); float sq = 0.f, sk = 0.f;
#pragma unroll
        for (int j = 0; j < 4; ++j) { const float a0 = bflo(q[j]), a1 = bfhi(q[j]); sq += a0 * a0 + a1 * a1; }
        if (hl < 16) { const u32x4 k = *(const u32x4*)(C + (size_t)row * 512 + 256 + 8 * hl);
#pragma unroll
            for (int j = 0; j < 4; ++j) { const float a0 = bflo(k[j]), a1 = bfhi(k[j]); sk += a0 * a0 + a1 * a1; } }
        sq = half_sum(sq); sk = half_sum(sk);
        if (hl == 0) { rq[row] = 1.0f / sqrtf(sq * (1.0f / 256.0f) + EPS); rkv[row] = 1.0f / sqrtf(sk * (1.0f / 128.0f) + EPS); }
    }
}

__device__ __forceinline__ void phase_kvprep(Frame& F) {
    KArgs ap = F.a; const bf16* KV = (const bf16*)(F.ws + WS_KVRAW); const bf16* C = (const bf16*)(F.ws + WS_C); const float* rkv = (const float*)(F.ws + WS_RKV); const float* rope = (const float*)(F.ws + WS_ROPE);
    bf16* Kf = (bf16*)(F.ws + WS_KF); bf16* Vt = (bf16*)(F.ws + WS_VF); const float* gk = ap->in[I_MKQK];
    const int gt = blockIdx.x * NTHR + F.tid, ngt = F.G * NTHR;
    for (int idx = gt; idx < T * NH; idx += ngt) {
        const int row = (idx >> 10) * 64 + (idx & 63), h = (idx >> 6) & 15; const float r = rkv[row];
        int b, pos; if (row < TC) { b = row >> 8; pos = row & 255; } else { b = (row - TC) >> 11; pos = CTXL + ((row - TC) & 2047); }
        const bf16* src = KV + (size_t)row * 2048 + h * 128;
        float kr[32]; float ss = 0.f;
#pragma unroll
        for (int q = 0; q < 8; ++q) { const u32x4 w = *(const u32x4*)(src + 8 * q);
#pragma unroll
            for (int j = 0; j < 4; ++j) { const float a0 = bflo(w[j]) * r, a1 = bfhi(w[j]) * r; ss += a0 * a0 + a1 * a1; } }
#pragma unroll
        for (int q = 0; q < 4; ++q) { const u32x4 w = *(const u32x4*)(C + (size_t)row * 512 + 384 + 8 * q);
#pragma unroll
            for (int j = 0; j < 4; ++j) { kr[8 * q + 2 * j] = bflo(w[j]); kr[8 * q + 2 * j + 1] = bfhi(w[j]); ss += kr[8 * q + 2 * j] * kr[8 * q + 2 * j] + kr[8 * q + 2 * j + 1] * kr[8 * q + 2 * j + 1]; } }
        const float rn = 1.0f / sqrtf(ss * (1.0f / 96.0f) + EPS);
        bf16* kd = Kf + ((size_t)(b * NH + h) * KVLEN + pos) * QK;
        asm volatile("" ::: "memory");
#pragma unroll 1
        for (int q = 0; q < 8; ++q) { const u32x4 w = *(const u32x4*)(src + 8 * q); const f32x4 g0 = *(const f32x4*)(gk + 8 * q), g1 = *(const f32x4*)(gk + 8 * q + 4); const float sc = r * rn; u32x4 o;
            o.x = cvtpk(bflo(w.x) * sc * g0.x, bfhi(w.x) * sc * g0.y); o.y = cvtpk(bflo(w.y) * sc * g0.z, bfhi(w.y) * sc * g0.w); o.z = cvtpk(bflo(w.z) * sc * g1.x, bfhi(w.z) * sc * g1.y); o.w = cvtpk(bflo(w.w) * sc * g1.z, bfhi(w.w) * sc * g1.w);
            *(u32x4*)(kd + 8 * q) = o; }
#pragma unroll
        for (int d = 0; d < 32; ++d) kr[d] = kr[d] * rn * gk[64 + d];
        if (row >= TC) { const int t = pos - CTXL; const int pr = t >> 6, pc = t & 63;
#pragma unroll
            for (int ax = 0; ax < 2; ++ax) { const int p = ax ? pc : pr;
#pragma unroll
                for (int i = 0; i < 8; ++i) { const float cs = rope[(p * 8 + i) * 2], sn = rope[(p * 8 + i) * 2 + 1]; const float x1 = kr[16 * ax + i], x2 = kr[16 * ax + 8 + i];
                    kr[16 * ax + i] = x1 * cs - x2 * sn; kr[16 * ax + 8 + i] = x2 * cs + x1 * sn; } } }
#pragma unroll
        for (int q = 0; q < 4; ++q) { u32x4 w; w.x = cvtpk(kr[8 * q], kr[8 * q + 1]); w.y = cvtpk(kr[8 * q + 2], kr[8 * q + 3]); w.z = cvtpk(kr[8 * q + 4], kr[8 * q + 5]); w.w = cvtpk(kr[8 * q + 6], kr[8 * q + 7]); *(u32x4*)(kd + 64 + 8 * q) = w; }
        const int u = (pos & ~12) | ((pos & 4) << 1) | ((pos & 8) >> 1);
        bf16* vd = Vt + (size_t)(b * NH + h) * VD * KVLEN + u;
#pragma unroll 1
        for (int q = 0; q < 8; ++q) { const u32x4 w = *(const u32x4*)(src + 64 + 8 * q);
#pragma unroll
            for (int j = 0; j < 4; ++j) { const unsigned o = cvtpk(bflo(w[j]) * r, bfhi(w[j]) * r); vd[(size_t)(8 * q + 2 * j) * KVLEN] = (bf16)(o & 0xffffu); vd[(size_t)(8 * q + 2 * j + 1) * KVLEN] = (bf16)(o >> 16); } }
    }
}

__device__ __forceinline__ void phase_attn(Frame& F) {
    KArgs ap = F.a; const bf16* Cb = (const bf16*)(F.ws + WS_C); const bf16* Wq = (const bf16*)(F.ws + WS_WQB); const bf16* Kf = (const bf16*)(F.ws + WS_KF); const bf16* Vt = (const bf16*)(F.ws + WS_VF);
    const float* rope = (const float*)(F.ws + WS_ROPE); bf16* AO = (bf16*)(F.ws + WS_AO); const float* gq = ap->in[I_MQQK]; const float* gk = ap->in[I_MKQK];
    const int tid = F.tid, lane = F.lane, r32 = lane & 31, hi = lane >> 5, wave = F.wave;
    constexpr float SC = 0.10206207261596577f * 1.4426950408889634f;
    float gqm = 0.f, gkm = 0.f;
    for (int d = 0; d < QK; ++d) { gqm = fmaxf(gqm, fabsf(gq[d])); gkm = fmaxf(gkm, fabsf(gk[d])); }
    const float negm = -(9.797958971132712f * 1.4426950408889634f) * gqm * gkm;
#if ATT_FP8
    const int sr = tid >> 3, scn = tid & 7;
    const int dKA = sr * 128 + ((scn ^ ((sr >> 1) & 7)) << 4);
    const int t2 = tid - 256, br = t2 >> 2, bc = t2 & 3;
    const int dKB = 8192 + br * 64 + ((bc ^ ((br >> 2) & 3)) << 4);
    constexpr int ABUF = 12288;
#else
    const int sr = tid >> 3, scn = tid & 7;
    const int dKA = sr * 128 + ((scn ^ ((sr >> 1) & 7)) << 4), dVT = 12288 + dKA;
    const int t2 = tid - 256, br = t2 >> 2, bc = t2 & 3;
    const int dKB = 8192 + br * 64 + ((bc ^ ((br >> 2) & 3)) << 4);
    constexpr int ABUF = 20480;
#endif
    const int sw7 = (r32 >> 1) & 7, sw3 = (r32 >> 2) & 3;
    constexpr int OST_OFF = 40960 + 49152;
    constexpr int WQ_OFF = 40960;
    int h_staged = -1;
    for (int unit = blockIdx.x; unit < NB * NH * 8; unit += F.G) {
        const int b = unit >> 7, h = (unit >> 3) & 15, qb = unit & 7; const int tq = qb * 256 + wave * 32 + r32; const int lrow = b * SEQ + tq;
        if (h != h_staged) {
            __syncthreads();
            int tidq = tid; asm volatile("" : "+v"(tidq));
#pragma unroll
            for (int i = 0; i < 6; ++i) { const int p = tidq + 512 * i, wrow = p >> 5, wch = p & 31;
                *(LAS u32x4*)(F.lds + WQ_OFF + wrow * 512 + ((wch ^ (wrow & 15)) << 4)) = *(const u32x4*)(Wq + ((size_t)h * 96 + wrow) * 256 + wch * 8); }
            h_staged = h;
            __syncthreads();
        }
#if ATT_FP8
        const unsigned char* Kh8 = (const unsigned char*)Kf + (size_t)(b * NH + h) * KVLEN * 128; const unsigned char* Vh8 = (const unsigned char*)Vt + (size_t)(b * NH + h) * VD * KVLEN;
        const unsigned char* gKA = Kh8 + (size_t)sr * 128 + scn * 16; const unsigned char* gKB = Vh8 + (size_t)br * KVLEN + bc * 16;
        u32x4 rKA = *(const u32x4*)gKA, rKB = (u32x4){0u, 0u, 0u, 0u};
        if (tid >= 256) rKB = *(const u32x4*)gKB;
#else
        const bf16* Kh = Kf + (size_t)(b * NH + h) * KVLEN * QK; const bf16* Vh = Vt + (size_t)(b * NH + h) * VD * KVLEN;
        const bf16* gKA = Kh + (size_t)sr * QK + scn * 8; const bf16* gKB = Kh + (size_t)br * QK + 64 + bc * 8; const bf16* gVT = Vh + (size_t)sr * KVLEN + scn * 8;
        u32x4 rKA = *(const u32x4*)gKA, rVT = *(const u32x4*)gVT, rKB = (u32x4){0u, 0u, 0u, 0u};
        if (tid >= 256) rKB = *(const u32x4*)gKB;
#endif
        typedef int v8i_t __attribute__((ext_vector_type(8))); typedef int v4i_t __attribute__((ext_vector_type(4)));
        bf16x8 qf[6]; v8i_t qf8[2]; (void)qf; (void)qf8;
        {
            const bf16* crow_p = Cb + (size_t)(TC + lrow) * 512 + 8 * hi;
            f32x16 qa[3]; qa[0] = (f32x16){}; qa[1] = (f32x16){}; qa[2] = (f32x16){};
            float ssc = 0.f;
            int r32q = r32; asm volatile("" : "+v"(r32q));
            const LAS unsigned char* wbase = F.lds + WQ_OFF + r32q * 512;
#pragma unroll
            for (int kh = 0; kh < 2; ++kh) {
                u32x4 cw[8];
#pragma unroll
                for (int k8 = 0; k8 < 8; ++k8) cw[k8] = *(const u32x4*)(crow_p + 16 * (8 * kh + k8));
#pragma unroll
                for (int k8 = 0; k8 < 8; ++k8) { const int ks = 8 * kh + k8; const bf16x8 cf = __builtin_bit_cast(bf16x8, cw[k8]);
#pragma unroll
                    for (int j = 0; j < 4; ++j) { const float a0 = bflo(cw[k8][j]), a1 = bfhi(cw[k8][j]); ssc += a0 * a0 + a1 * a1; }
#pragma unroll
                    for (int nt = 0; nt < 3; ++nt) { const bf16x8 wf = *(const LAS bf16x8*)(wbase + nt * 32 * 512 + (((2 * ks + hi) ^ (r32q & 15)) << 4)); qa[nt] = __builtin_amdgcn_mfma_f32_32x32x16_bf16(wf, cf, qa[nt], 0, 0, 0); }
                    if (k8 & 1) __builtin_amdgcn_sched_barrier(0); }
                asm volatile("" ::: "memory");
            }
            ssc += __shfl_xor(ssc, 32);
            const float r = 1.0f / sqrtf(ssc * (1.0f / 256.0f) + EPS);
            float ss = 0.f;
#pragma unroll
            for (int nt = 0; nt < 3; ++nt)
#pragma unroll
                for (int i = 0; i < 16; ++i) { qa[nt][i] *= r; ss += qa[nt][i] * qa[nt][i]; }
            ss += __shfl_xor(ss, 32);
            const float rn = 1.0f / sqrtf(ss * (1.0f / 96.0f) + EPS);
#pragma unroll
            for (int nt = 0; nt < 3; ++nt)
#pragma unroll
                for (int i = 0; i < 16; ++i) qa[nt][i] *= rn * gq[32 * nt + 16 * (i >> 3) + 8 * hi + (i & 7)];
            const int pr = tq >> 6, pc = tq & 63;
#pragma unroll
            for (int ax = 0; ax < 2; ++ax) { const int p = ax ? pc : pr;
#pragma unroll
                for (int j = 0; j < 8; ++j) { const float mine = qa[2][8 * ax + j]; const float other = __shfl_xor(mine, 32); const float cs = rope[(p * 8 + j) * 2], sn = rope[(p * 8 + j) * 2 + 1];
                    qa[2][8 * ax + j] = mine * cs + (hi ? other : -other) * sn; } }
#if ATT_FP8
#pragma unroll
            for (int sx = 0; sx < 2; ++sx) { v8i_t w;
#pragma unroll
                for (int q4 = 0; q4 < 4; ++q4) w[q4] = (int)pk4_fp8(qa[2 * sx][4 * q4] * (8.f * SC), qa[2 * sx][4 * q4 + 1] * (8.f * SC), qa[2 * sx][4 * q4 + 2] * (8.f * SC), qa[2 * sx][4 * q4 + 3] * (8.f * SC));
#pragma unroll
                for (int q4 = 0; q4 < 4; ++q4) w[4 + q4] = sx ? 0 : (int)pk4_fp8(qa[1][4 * q4] * (8.f * SC), qa[1][4 * q4 + 1] * (8.f * SC), qa[1][4 * q4 + 2] * (8.f * SC), qa[1][4 * q4 + 3] * (8.f * SC));
                qf8[sx] = w; }
#else
#pragma unroll
            for (int ks = 0; ks < 6; ++ks) { const int nt = ks >> 1, o = 8 * (ks & 1); u32x4 w;
                w.x = cvtpk(qa[nt][o] * SC, qa[nt][o + 1] * SC); w.y = cvtpk(qa[nt][o + 2] * SC, qa[nt][o + 3] * SC); w.z = cvtpk(qa[nt][o + 4] * SC, qa[nt][o + 5] * SC); w.w = cvtpk(qa[nt][o + 6] * SC, qa[nt][o + 7] * SC);
                qf[ks] = __builtin_bit_cast(bf16x8, w); }
#endif
        }
        f32x16 o0 = {}, o1 = {}; float lsum = 0.f;
#if ATT_FP8
        *(LAS u32x4*)(F.lds + dKA) = rKA; if (tid >= 256) *(LAS u32x4*)(F.lds + dKB) = rKB;
        __syncthreads();
        constexpr int NT = KVLEN / 64;
        f32x16 negv;
#pragma unroll
        for (int r = 0; r < 16; ++r) negv[r] = -1.0f;
        asm volatile("" : "+v"(negv));
        const int oK0 = r32 * 128 + (((0 + 2 * hi) ^ sw7) << 4), oK1 = r32 * 128 + (((1 + 2 * hi) ^ sw7) << 4), oK2 = r32 * 128 + (((4 + 2 * hi) ^ sw7) << 4), oK3 = r32 * 128 + (((5 + 2 * hi) ^ sw7) << 4);
        const int oV0 = 8192 + r32 * 64 + (((2 * hi) ^ sw3) << 4), oV1 = 8192 + r32 * 64 + (((2 * hi + 1) ^ sw3) << 4);
#define LD32(p0, p1) __builtin_shufflevector(*(const LAS v4i_t*)(p0), *(const LAS v4i_t*)(p1), 0, 1, 2, 3, 4, 5, 6, 7)
        for (int t = 0; t < NT; ++t) {
            const LAS unsigned char* buf = F.lds + (t & 1) * ABUF;
            if (t + 1 < NT) { rKA = *(const u32x4*)(gKA + (size_t)(t + 1) * 64 * 128); if (tid >= 256) rKB = *(const u32x4*)(gKB + (t + 1) * 64); }
            const v8i_t k00 = LD32(buf + oK0, buf + oK1), k01 = LD32(buf + oK2, buf + oK3), k10 = LD32(buf + oK0 + 4096, buf + oK1 + 4096), k11 = LD32(buf + oK2 + 4096, buf + oK3 + 4096);
            f32x16 s0 = __builtin_amdgcn_mfma_scale_f32_32x32x64_f8f6f4(k00, qf8[0], negv, 0, 0, 0, 0x7f7f7f7f, 0, 0x7c7c7c7c);
            f32x16 s1 = __builtin_amdgcn_mfma_scale_f32_32x32x64_f8f6f4(k10, qf8[0], negv, 0, 0, 0, 0x7f7f7f7f, 0, 0x7c7c7c7c);
            s0 = __builtin_amdgcn_mfma_scale_f32_32x32x64_f8f6f4(k01, qf8[1], s0, 0, 0, 0, 0x7f7f7f7f, 0, 0x7c7c7c7c);
            s1 = __builtin_amdgcn_mfma_scale_f32_32x32x64_f8f6f4(k11, qf8[1], s1, 0, 0, 0, 0x7f7f7f7f, 0, 0x7c7c7c7c);
            const v8i_t v0 = LD32(buf + oV0, buf + oV1), v1 = LD32(buf + oV0 + 2048, buf + oV1 + 2048);
            float ls = 0.f;
#pragma unroll
            for (int r = 0; r < 16; ++r) { s0[r] = __builtin_amdgcn_exp2f(s0[r]); s1[r] = __builtin_amdgcn_exp2f(s1[r]); ls += s0[r] + s1[r]; }
            lsum += ls;
            v8i_t pw;
#pragma unroll
            for (int q4 = 0; q4 < 4; ++q4) { pw[q4] = (int)pk4_fp8(s0[4 * q4], s0[4 * q4 + 1], s0[4 * q4 + 2], s0[4 * q4 + 3]); pw[4 + q4] = (int)pk4_fp8(s1[4 * q4], s1[4 * q4 + 1], s1[4 * q4 + 2], s1[4 * q4 + 3]); }
            o0 = __builtin_amdgcn_mfma_scale_f32_32x32x64_f8f6f4(v0, pw, o0, 0, 0, 0, 0x7f7f7f7f, 0, 0x7f7f7f7f);
            o1 = __builtin_amdgcn_mfma_scale_f32_32x32x64_f8f6f4(v1, pw, o1, 0, 0, 0, 0x7f7f7f7f, 0, 0x7f7f7f7f);
            if (t + 1 < NT) { LAS unsigned char* nb = F.lds + ((t + 1) & 1) * ABUF; *(LAS u32x4*)(nb + dKA) = rKA; if (tid >= 256) *(LAS u32x4*)(nb + dKB) = rKB; }
            __syncthreads();
        }
#undef LD32
#else
        *(LAS u32x4*)(F.lds + dKA) = rKA; *(LAS u32x4*)(F.lds + dVT) = rVT; if (tid >= 256) *(LAS u32x4*)(F.lds + dKB) = rKB;
        __syncthreads();
        constexpr int NT = KVLEN / 64;
        for (int t = 0; t < NT; ++t) {
            LAS unsigned char* buf = F.lds + (t & 1) * 20480;
            if (t + 1 < NT) { rKA = *(const u32x4*)(gKA + (size_t)(t + 1) * 64 * QK); rVT = *(const u32x4*)(gVT + (t + 1) * 64); if (tid >= 256) rKB = *(const u32x4*)(gKB + (size_t)(t + 1) * 64 * QK); }
            f32x16 s0, s1;
#pragma unroll
            for (int r = 0; r < 16; ++r) { s0[r] = negm; s1[r] = negm; }
#pragma unroll
            for (int ks = 0; ks < 6; ++ks) {
                const int off = (ks < 4) ? (r32 * 128 + (((2 * ks + hi) ^ sw7) << 4)) : (8192 + r32 * 64 + (((2 * (ks - 4) + hi) ^ sw3) << 4));
                const bf16x8 a0 = *(const LAS bf16x8*)(buf + off), a1 = *(const LAS bf16x8*)(buf + off + ((ks < 4) ? 4096 : 2048));
                s0 = __builtin_amdgcn_mfma_f32_32x32x16_bf16(a0, qf[ks], s0, 0, 0, 0); s1 = __builtin_amdgcn_mfma_f32_32x32x16_bf16(a1, qf[ks], s1, 0, 0, 0);
            }
            float ls = 0.f;
#pragma unroll
            for (int r = 0; r < 16; ++r) { s0[r] = __builtin_amdgcn_exp2f(s0[r]); s1[r] = __builtin_amdgcn_exp2f(s1[r]); ls += s0[r] + s1[r]; }
            lsum += ls;
            bf16x8 pw[4];
            { u32x4 w;
              w.x = cvtpk(s0[0], s0[1]); w.y = cvtpk(s0[2], s0[3]); w.z = cvtpk(s0[4], s0[5]); w.w = cvtpk(s0[6], s0[7]); pw[0] = __builtin_bit_cast(bf16x8, w);
              w.x = cvtpk(s0[8], s0[9]); w.y = cvtpk(s0[10], s0[11]); w.z = cvtpk(s0[12], s0[13]); w.w = cvtpk(s0[14], s0[15]); pw[1] = __builtin_bit_cast(bf16x8, w);
              w.x = cvtpk(s1[0], s1[1]); w.y = cvtpk(s1[2], s1[3]); w.z = cvtpk(s1[4], s1[5]); w.w = cvtpk(s1[6], s1[7]); pw[2] = __builtin_bit_cast(bf16x8, w);
              w.x = cvtpk(s1[8], s1[9]); w.y = cvtpk(s1[10], s1[11]); w.z = cvtpk(s1[12], s1[13]); w.w = cvtpk(s1[14], s1[15]); pw[3] = __builtin_bit_cast(bf16x8, w); }
#pragma unroll
            for (int s = 0; s < 4; ++s) {
                const int off = 12288 + r32 * 128 + (((2 * s + hi) ^ sw7) << 4);
                const bf16x8 v0 = *(const LAS bf16x8*)(buf + off), v1 = *(const LAS bf16x8*)(buf + off + 4096);
                o0 = __builtin_amdgcn_mfma_f32_32x32x16_bf16(v0, pw[s], o0, 0, 0, 0); o1 = __builtin_amdgcn_mfma_f32_32x32x16_bf16(v1, pw[s], o1, 0, 0, 0);
            }
            if (t + 1 < NT) { LAS unsigned char* nb = F.lds + ((t + 1) & 1) * 20480; *(LAS u32x4*)(nb + dKA) = rKA; *(LAS u32x4*)(nb + dVT) = rVT; if (tid >= 256) *(LAS u32x4*)(nb + dKB) = rKB; }
            __syncthreads();
        }
#endif
        lsum += __shfl_xor(lsum, 32);
        const float il = 1.0f / lsum;
        LAS unsigned char* ost = F.lds + OST_OFF + wave * 4608;
#pragma unroll
        for (int g = 0; g < 4; ++g) { u32x2 w0, w1; w0.x = cvtpk(o0[4 * g] * il, o0[4 * g + 1] * il); w0.y = cvtpk(o0[4 * g + 2] * il, o0[4 * g + 3] * il); w1.x = cvtpk(o1[4 * g] * il, o1[4 * g + 1] * il); w1.y = cvtpk(o1[4 * g + 2] * il, o1[4 * g + 3] * il);
            *(LAS u32x2*)(ost + r32 * 144 + (8 * g + 4 * hi) * 2) = w0; *(LAS u32x2*)(ost + r32 * 144 + (32 + 8 * g + 4 * hi) * 2) = w1; }
        asm volatile("s_waitcnt lgkmcnt(0)" ::: "memory");
        bf16* dstw = AO + ((size_t)b * SEQ + qb * 256 + wave * 32) * D + h * 64;
#pragma unroll
        for (int i = 0; i < 4; ++i) { const int row = 8 * i + (lane >> 3), ch = lane & 7; *(u32x4*)(dstw + (size_t)row * D + ch * 8) = *(const LAS u32x4*)(ost + row * 144 + ch * 16); }
    }
}

__device__ __forceinline__ void phase_attn8x2(Frame& F) {
    KArgs ap = F.a; const bf16* Cb = (const bf16*)(F.ws + WS_C); const bf16* Wq = (const bf16*)(F.ws + WS_WQB); const unsigned char* Kf8 = (const unsigned char*)(F.ws + WS_KF); const unsigned char* Vt8 = (const unsigned char*)(F.ws + WS_VF);
    const float* rope = (const float*)(F.ws + WS_ROPE); bf16* AO = (bf16*)(F.ws + WS_AO); const float* gq = ap->in[I_MQQK];
    const int wave = F.wave;
    constexpr float SC8 = 8.0f * 0.10206207261596577f * 1.4426950408889634f;
    typedef int v8i_t __attribute__((ext_vector_type(8))); typedef int v4i_t __attribute__((ext_vector_type(4)));
    constexpr int KPITCH = 144, VPITCH = 80, VOFF = 64 * KPITCH, ABUF = VOFF + 64 * VPITCH;
    constexpr int WQ_OFF = 2 * ABUF, TAB_OFF = WQ_OFF + 49152, OST_OFF = TAB_OFF + 4608;
    static_assert(OST_OFF + 8 * 8192 <= MISC_OFF, "attention LDS map");
    int h_staged = -1;
    for (int unit = blockIdx.x; unit < NB * NH * 4; unit += F.G) {
        const int b = unit >> 6, h = (unit >> 2) & 15, qb2 = unit & 3;
        int lane = (int)__builtin_amdgcn_mbcnt_hi(~0u, __builtin_amdgcn_mbcnt_lo(~0u, 0u)); asm volatile("" : "+v"(lane));
        const int tid = wave * 64 + lane, tidu = tid, r32 = lane & 31, hi = lane >> 5, r32u = r32, hiu = hi;
        const int sr = tidu >> 3, scn = tidu & 7;
        const int dKA = sr * KPITCH + scn * 16;
        const int t2 = tidu - 256, br = t2 >> 2, bc = t2 & 3;
        const int dKB = VOFF + br * VPITCH + bc * 16;
        if (h != h_staged) {
            __syncthreads();
            int tidq = tid; asm volatile("" : "+v"(tidq));
#pragma unroll
            for (int i = 0; i < 6; ++i) { const int p = tidq + 512 * i, wrow = p >> 5, wch = p & 31;
                *(LAS u32x4*)(F.lds + WQ_OFF + wrow * 512 + ((wch ^ (wrow & 15)) << 4)) = *(const u32x4*)(Wq + ((size_t)h * 96 + wrow) * 256 + wch * 8); }
            for (int i = tidq; i < 96 + 1024; i += NTHR) ((LAS float*)(F.lds + TAB_OFF))[i] = (i < 96) ? gq[i] : rope[i - 96];
            h_staged = h;
            __syncthreads();
        }
        const unsigned char* Kh8 = Kf8 + (size_t)(b * NH + h) * KVLEN * 128; const unsigned char* Vh8 = Vt8 + (size_t)(b * NH + h) * VD * KVLEN;
        const unsigned char* gKA = Kh8 + (size_t)sr * 128 + scn * 16; const unsigned char* gKB = Vh8 + (size_t)br * KVLEN + bc * 16;
        u32x4 rKA = *(const u32x4*)gKA, rKB = (u32x4){0u, 0u, 0u, 0u};
        if (tid >= 256) rKB = *(const u32x4*)gKB;
        LAS unsigned char* qst = F.lds + OST_OFF + wave * 8192;
#pragma unroll 1
        for (int u = 0; u < 2; ++u) {
            int r32q = r32, hiq = hi; asm volatile("" : "+v"(r32q), "+v"(hiq));
            const int tq = qb2 * 512 + u * 256 + wave * 32 + r32q; const int lrow = b * SEQ + tq;
            const bf16* crow_p = Cb + (size_t)(TC + lrow) * 512 + 8 * hiq;
            f32x16 qa[3]; qa[0] = (f32x16){}; qa[1] = (f32x16){}; qa[2] = (f32x16){};
            float ssc = 0.f;
            const LAS unsigned char* wbase = F.lds + WQ_OFF + r32q * 512;
            u32x4 cwa[16];
#pragma unroll
            for (int k16 = 0; k16 < 16; ++k16) cwa[k16] = *(const u32x4*)(crow_p + 16 * k16);
            { const f32x4 q4 = *(const f32x4*)((const float*)(F.ws + WS_SSQ) + (size_t)(TC + lrow) * 4); ssc = 0.5f * ((q4.x + q4.y) + (q4.z + q4.w)); }
#pragma unroll
            for (int kq = 0; kq < 4; ++kq) {
#pragma unroll
                for (int k4 = 0; k4 < 4; ++k4) { const int ks = 4 * kq + k4; const bf16x8 cf = __builtin_bit_cast(bf16x8, cwa[ks]);
#pragma unroll
                    for (int nt = 0; nt < 3; ++nt) { const bf16x8 wf = *(const LAS bf16x8*)(wbase + nt * 32 * 512 + (((2 * ks + hiq) ^ (r32q & 15)) << 4)); qa[nt] = __builtin_amdgcn_mfma_f32_32x32x16_bf16(wf, cf, qa[nt], 0, 0, 0); }
                    __builtin_amdgcn_sched_barrier(0); }
                asm volatile("" ::: "memory");
            }
            ssc += __shfl_xor(ssc, 32);
            const float r = 1.0f / sqrtf(ssc * (1.0f / 256.0f) + EPS);
            float ss = 0.f;
#pragma unroll
            for (int nt = 0; nt < 3; ++nt)
#pragma unroll
                for (int i = 0; i < 16; ++i) { qa[nt][i] *= r; ss += qa[nt][i] * qa[nt][i]; }
            ss += __shfl_xor(ss, 32);
            const float rn = 1.0f / sqrtf(ss * (1.0f / 96.0f) + EPS);
#pragma unroll
            for (int nt = 0; nt < 3; ++nt)
#pragma unroll
                for (int i = 0; i < 16; ++i) qa[nt][i] *= rn * ((const LAS float*)(F.lds + TAB_OFF))[32 * nt + 16 * (i >> 3) + 8 * hiq + (i & 7)];
            const int pr = tq >> 6, pc = tq & 63;
#pragma unroll
            for (int ax = 0; ax < 2; ++ax) { const int p = ax ? pc : pr;
#pragma unroll
                for (int j = 0; j < 8; ++j) { const float mine = qa[2][8 * ax + j]; const float other = __shfl_xor(mine, 32); const f32x2_t csn = *(const LAS f32x2_t*)(F.lds + TAB_OFF + 384 + (p * 8 + j) * 8);
                    qa[2][8 * ax + j] = mine * csn.x + (hiq ? other : -other) * csn.y; } }
#pragma unroll
            for (int sx = 0; sx < 2; ++sx) { v8i_t w;
#pragma unroll
                for (int q4 = 0; q4 < 4; ++q4) w[q4] = (int)pk4_fp8(qa[2 * sx][4 * q4] * SC8, qa[2 * sx][4 * q4 + 1] * SC8, qa[2 * sx][4 * q4 + 2] * SC8, qa[2 * sx][4 * q4 + 3] * SC8);
#pragma unroll
                for (int q4 = 0; q4 < 4; ++q4) w[4 + q4] = sx ? 0 : (int)pk4_fp8(qa[1][4 * q4] * SC8, qa[1][4 * q4 + 1] * SC8, qa[1][4 * q4 + 2] * SC8, qa[1][4 * q4 + 3] * SC8);
                *(LAS v4i_t*)(qst + (u * 2 + sx) * 2048 + lane * 32) = __builtin_shufflevector(w, w, 0, 1, 2, 3); *(LAS v4i_t*)(qst + (u * 2 + sx) * 2048 + lane * 32 + 16) = __builtin_shufflevector(w, w, 4, 5, 6, 7); }
        }
        asm volatile("s_waitcnt lgkmcnt(0)" ::: "memory");
        v8i_t qf8[2][2];
#pragma unroll
        for (int u = 0; u < 2; ++u)
#pragma unroll
            for (int sx = 0; sx < 2; ++sx) qf8[u][sx] = __builtin_shufflevector(*(const LAS v4i_t*)(qst + (u * 2 + sx) * 2048 + lane * 32), *(const LAS v4i_t*)(qst + (u * 2 + sx) * 2048 + lane * 32 + 16), 0, 1, 2, 3, 4, 5, 6, 7);
        f32x16 o[2][2]; f32x4 lacc[2]; lacc[0] = (f32x4){0.f, 0.f, 0.f, 0.f}; lacc[1] = lacc[0];
        v8i_t sel; { const int one4 = (lane == 0 || lane == 32 || lane == 17 || lane == 49) ? 0x38383838 : 0;
#pragma unroll
            for (int i = 0; i < 8; ++i) sel[i] = one4; }
#pragma unroll
        for (int u = 0; u < 2; ++u) { o[u][0] = (f32x16){}; o[u][1] = (f32x16){}; }
        *(LAS u32x4*)(F.lds + dKA) = rKA; if (tid >= 256) *(LAS u32x4*)(F.lds + dKB) = rKB;
        __syncthreads();
        constexpr int NT = KVLEN / 64;
        const f32x16 zero16 = {};
        const int oK = r32u * KPITCH + 32 * hiu, oV = VOFF + r32u * VPITCH + 32 * hiu;
#define LD32(p0, p1) __builtin_shufflevector(*(const LAS v4i_t*)(p0), *(const LAS v4i_t*)(p1), 0, 1, 2, 3, 4, 5, 6, 7)
        for (int t = 0; t < NT; ++t) {
            const LAS unsigned char* buf = F.lds + (t & 1) * ABUF;
            if (t + 1 < NT) { rKA = *(const u32x4*)(gKA + (size_t)(t + 1) * 64 * 128); if (tid >= 256) rKB = *(const u32x4*)(gKB + (t + 1) * 64); }
            const v8i_t k00 = LD32(buf + oK, buf + oK + 16), k01 = LD32(buf + oK + 64, buf + oK + 80), k10 = LD32(buf + oK + 32 * KPITCH, buf + oK + 32 * KPITCH + 16), k11 = LD32(buf + oK + 32 * KPITCH + 64, buf + oK + 32 * KPITCH + 80);
            const v8i_t v0 = LD32(buf + oV, buf + oV + 16), v1 = LD32(buf + oV + 32 * VPITCH, buf + oV + 32 * VPITCH + 16);
            f32x16 sa[2], sb[2]; v8i_t pw[2];
#define QKM(acc, kf, qf, cin) acc = __builtin_amdgcn_mfma_scale_f32_32x32x64_f8f6f4(kf, qf, cin, 0, 0, 0, 0x7f7f7f7f, 0, 0x7c7c7c7c)
#define EXP8(v, lo) do { _Pragma("unroll") for (int r = (lo); r < (lo) + 8; ++r) v[r] = __builtin_amdgcn_exp2f(v[r]); } while (0)
#define PACK(u, v, lo, dst0) do { _Pragma("unroll") for (int q4 = (lo) / 4; q4 < (lo) / 4 + 2; ++q4) pw[u][(dst0) + q4] = (int)pk4_fp8(v[4 * q4], v[4 * q4 + 1], v[4 * q4 + 2], v[4 * q4 + 3]); } while (0)
#define SB() __builtin_amdgcn_sched_barrier(0)
            QKM(sa[0], k00, qf8[0][0], zero16); QKM(sb[0], k10, qf8[0][0], zero16); QKM(sa[0], k01, qf8[0][1], sa[0]); QKM(sb[0], k11, qf8[0][1], sb[0]); SB();
            QKM(sa[1], k00, qf8[1][0], zero16); EXP8(sa[0], 0); SB();
            QKM(sb[1], k10, qf8[1][0], zero16); EXP8(sa[0], 8); SB();
            QKM(sa[1], k01, qf8[1][1], sa[1]); EXP8(sb[0], 0); PACK(0, sa[0], 0, 0); SB();
            QKM(sb[1], k11, qf8[1][1], sb[1]); EXP8(sb[0], 8); PACK(0, sa[0], 8, 0); SB();
            PACK(0, sb[0], 0, 4); PACK(0, sb[0], 8, 4); SB();
            o[0][0] = __builtin_amdgcn_mfma_scale_f32_32x32x64_f8f6f4(v0, pw[0], o[0][0], 0, 0, 0, 0x7f7f7f7f, 0, 0x7f7f7f7f); EXP8(sa[1], 0); SB();
            o[0][1] = __builtin_amdgcn_mfma_scale_f32_32x32x64_f8f6f4(v1, pw[0], o[0][1], 0, 0, 0, 0x7f7f7f7f, 0, 0x7f7f7f7f); EXP8(sa[1], 8); SB();
            lacc[0] = __builtin_amdgcn_mfma_scale_f32_16x16x128_f8f6f4(sel, pw[0], lacc[0], 0, 0, 0, 0x7f7f7f7f, 0, 0x7f7f7f7f); EXP8(sb[1], 0); PACK(1, sa[1], 0, 0); SB();
            EXP8(sb[1], 8); PACK(1, sa[1], 8, 0); PACK(1, sb[1], 0, 4); PACK(1, sb[1], 8, 4); SB();
            o[1][0] = __builtin_amdgcn_mfma_scale_f32_32x32x64_f8f6f4(v0, pw[1], o[1][0], 0, 0, 0, 0x7f7f7f7f, 0, 0x7f7f7f7f);
            o[1][1] = __builtin_amdgcn_mfma_scale_f32_32x32x64_f8f6f4(v1, pw[1], o[1][1], 0, 0, 0, 0x7f7f7f7f, 0, 0x7f7f7f7f);
            lacc[1] = __builtin_amdgcn_mfma_scale_f32_16x16x128_f8f6f4(sel, pw[1], lacc[1], 0, 0, 0, 0x7f7f7f7f, 0, 0x7f7f7f7f);
#undef QKM
#undef EXP8
#undef PACK
#undef SB
            if (t + 1 < NT) { LAS unsigned char* nb = F.lds + ((t + 1) & 1) * ABUF; *(LAS u32x4*)(nb + dKA) = rKA; if (tid >= 256) *(LAS u32x4*)(nb + dKB) = rKB; }
            __syncthreads();
        }
#undef LD32
        int lane_e = (int)__builtin_amdgcn_mbcnt_hi(~0u, __builtin_amdgcn_mbcnt_lo(~0u, 0u)); asm volatile("" : "+v"(lane_e)); const int r32e = lane_e & 31, hie = lane_e >> 5;
        LAS unsigned char* ost = F.lds + OST_OFF + wave * 8192;
#pragma unroll
        for (int u = 0; u < 2; ++u) {
            const float l0_ = __shfl(lacc[u][0], r32e & 15), l1_ = __shfl(lacc[u][1], r32e & 15); const float l = (r32e < 16) ? l0_ : l1_;
#if AO_FP8
            const float il = 16.0f / l;
#pragma unroll
            for (int g = 0; g < 4; ++g) { *(LAS unsigned*)(ost + r32e * 80 + 8 * g + 4 * hie) = pk4_fp8(o[u][0][4 * g] * il, o[u][0][4 * g + 1] * il, o[u][0][4 * g + 2] * il, o[u][0][4 * g + 3] * il);
                *(LAS unsigned*)(ost + r32e * 80 + 32 + 8 * g + 4 * hie) = pk4_fp8(o[u][1][4 * g] * il, o[u][1][4 * g + 1] * il, o[u][1][4 * g + 2] * il, o[u][1][4 * g + 3] * il); }
            asm volatile("s_waitcnt lgkmcnt(0)" ::: "memory");
            unsigned char* dstw = (unsigned char*)AO + ((size_t)b * SEQ + qb2 * 512 + u * 256 + wave * 32) * D + h * 64;
#pragma unroll
            for (int i = 0; i < 2; ++i) { const int row = 16 * i + (lane_e >> 2), ch = lane_e & 3; *(u32x4*)(dstw + (size_t)row * D + ch * 16) = *(const LAS u32x4*)(ost + row * 80 + ch * 16); }
            asm volatile("s_waitcnt lgkmcnt(0)" ::: "memory");
#else
            const float il = 1.0f / l;
#pragma unroll
            for (int g = 0; g < 4; ++g) { u32x2 w0, w1; w0.x = cvtpk(o[u][0][4 * g] * il, o[u][0][4 * g + 1] * il); w0.y = cvtpk(o[u][0][4 * g + 2] * il, o[u][0][4 * g + 3] * il); w1.x = cvtpk(o[u][1][4 * g] * il, o[u][1][4 * g + 1] * il); w1.y = cvtpk(o[u][1][4 * g + 2] * il, o[u][1][4 * g + 3] * il);
                *(LAS u32x2*)(ost + r32e * 144 + (8 * g + 4 * hie) * 2) = w0; *(LAS u32x2*)(ost + r32e * 144 + (32 + 8 * g + 4 * hie) * 2) = w1; }
            asm volatile("s_waitcnt lgkmcnt(0)" ::: "memory");
            bf16* dstw = AO + ((size_t)b * SEQ + qb2 * 512 + u * 256 + wave * 32) * D + h * 64;
#pragma unroll
            for (int i = 0; i < 4; ++i) { const int row = 8 * i + (lane_e >> 3), ch = lane_e & 7; *(u32x4*)(dstw + (size_t)row * D + ch * 8) = *(const LAS u32x4*)(ost + row * 144 + ch * 16); }
            asm volatile("s_waitcnt lgkmcnt(0)" ::: "memory");
#endif
        }
    }
}

constexpr int NPHASE = 23;
template <int PH> __global__ void __launch_bounds__(NTHR, 2) fwd_kernel(Args args) {
    extern __shared__ __attribute__((aligned(16))) unsigned char lds_raw[];
    Frame F;
    F.lds = (LAS unsigned char*)lds_raw;
    volatile LAS unsigned* MISC = (volatile LAS unsigned*)(F.lds + MISC_OFF);
    if (threadIdx.x < 32) MISC[threadIdx.x] = 0u;
    __syncthreads();
    const int wv0_ = __builtin_amdgcn_readfirstlane((int)(threadIdx.x >> 6));
    const int lo = args.ph_lo, hi = args.ph_hi;
#if MK_N_LAUNCHES == 1
    XcdBarrier bar = xcd_barrier_post((unsigned*)(args.ws + WS_CTL) + CW_BAR, MISC + 8);
#define GRID_BAR() xcd_barrier(bar)
#else
#define GRID_BAR() do {} while (0)
#endif
#define IN(k) ((PH < 0 || (k) == PH) && lo <= (k) && (k) < hi)
#define SEAM(k) do { if (IN(k) && IN((k) + 1)) GRID_BAR(); } while (0)
#define FRESH() { int t_ = wv0_ * 64 + (int)__builtin_amdgcn_mbcnt_hi(~0u, __builtin_amdgcn_mbcnt_lo(~0u, 0u)); asm volatile("" : "+v"(t_)); KArgs kp_ = (KArgs)__builtin_amdgcn_kernarg_segment_ptr(); asm volatile("" : "+s"(kp_)); \
        F.tid = t_; F.lane = t_ & 63; F.wave = __builtin_amdgcn_readfirstlane(t_ >> 6); F.G = gridDim.x; F.gw = blockIdx.x * NWAVES + F.wave; F.ngw = F.G * NWAVES; F.a = kp_; F.ws = kp_->ws; } \
        unsigned char* ws = F.ws; float* const outp = F.a->out; const float* mod0 = (const float*)(ws + WS_MOD); const float* mod1 = mod0 + 33 * 6144; (void)outp; (void)mod0; (void)mod1;

    if (IN(0)) { FRESH(); phase_prologue(F);
#if defined(DUP_PHASE) && DUP_PHASE == 0
        __syncthreads(); phase_prologue(F);
#endif
    } SEAM(0);
    if (IN(1)) { FRESH(); phase_ew0(F); phase_router_tables(F); } SEAM(1);
    if (IN(2)) {
        FRESH();
        pg8::Gemm g{(const bf16*)(ws + WS_H), D, 0, nullptr, (const bf16*)(ws + WS_W1T), 0, D, D, 0}; pg8::DenseOrder S; S.init(T, 5120, F.G, (int)blockIdx.x);
        pg8::EpiHgIn E{(bf16*)(ws + WS_P), (const float*)(ws + WS_LB)};
        pg8::gemm_phase<pg8::EpiHgIn, pg8::DenseOrder, false>(F.lds, g, S, E, F.wave);
    } SEAM(2);
    if (IN(3)) { FRESH(); phase_gla(F);
#if defined(DUP_PHASE) && DUP_PHASE == 3
        __syncthreads(); phase_gla(F);
#endif
    } SEAM(3);
    if (IN(5)) {
        FRESH();
#if HG_FP8
        pg8::Gemm g{(const bf16*)((const unsigned char*)outp + A8_OFF), 512, 0, nullptr, (const bf16*)(ws + WS_W2T), 0, 512, 512, 0}; pg8::DenseOrder S; S.init(T, D, F.G, (int)blockIdx.x);
        pg8::EpiResid E{F.a->in[I_CTX], F.a->in[I_X], nullptr, (bf16*)(ws + WS_X1), mod0 + 2 * 1024, 0, 1.0f / 256.0f};
        pg8::gemm_phase<pg8::EpiResid, pg8::DenseOrder, false, true>(F.lds, g, S, E, F.wave);
#else
        pg8::Gemm g{(const bf16*)outp, D, 0, nullptr, (const bf16*)(ws + WS_W2T), 0, D, D, 0}; pg8::DenseOrder S; S.init(T, D, F.G, (int)blockIdx.x);
        pg8::EpiResid E{F.a->in[I_CTX], F.a->in[I_X], nullptr, (bf16*)(ws + WS_X1), mod0 + 2 * 1024, 0, 1.0f};
        pg8::gemm_phase<pg8::EpiResid, pg8::DenseOrder, false>(F.lds, g, S, E, F.wave);
#endif
    } SEAM(5);
    const bool ew_router_fused = MOE_FP8 && (gridDim.x == 256);
    if (IN(6)) { FRESH(); phase_ew2(F, 0, (const bf16*)(ws + WS_X1), 0, 0, MOE_FP8 ? (unsigned char*)outp : nullptr);
        if (ew_router_fused) { asm volatile("s_waitcnt vmcnt(0)" ::: "memory"); __syncthreads(); phase_router(F, 0, 0, T / 256, (const bf16*)(ws + WS_X1), 0); } }
    if (!ew_router_fused) { SEAM(6); if (IN(7)) { FRESH(); phase_router(F, 0, 0, T / 256, (const bf16*)(ws + WS_X1), 0); } }
    do { if (IN(7) && IN(8)) GRID_BAR(); } while (0);
    if (IN(8)) { FRESH(); phase_assign(F, 0, T / 256); } SEAM(8);
    if (IN(9)) {
        FRESH();
        const int nblk = __builtin_amdgcn_readfirstlane(((const int*)(ws + WS_META))[0]);
#if MOE_FP8
        pg8::Gemm g{(const bf16*)outp, 512, 0, (const int*)(ws + WS_TOKROW), (const bf16*)(ws + WS_MOEW0), (size_t)1024 * 512, 512, 512, 0}; pg8::MoeOrder S; S.init((const int*)(ws + WS_BLKE), nblk, F.G, (int)blockIdx.x);
        pg8::EpiSwiGLU8 E{ws + WS_ACT};
        pg8::gemm_phase<pg8::EpiSwiGLU8, pg8::MoeOrder, true, true>(F.lds, g, S, E, F.wave);
#else
        pg8::Gemm g{(const bf16*)(ws + WS_H), D, 0, (const int*)(ws + WS_TOKROW), (const bf16*)(ws + WS_MOEW0), (size_t)1024 * 1024, D, D, 0}; pg8::MoeOrder S; S.init((const int*)(ws + WS_BLKE), nblk, F.G, (int)blockIdx.x);
        pg8::EpiSwiGLU E{(bf16*)(ws + WS_ACT)};
        pg8::gemm_phase<pg8::EpiSwiGLU, pg8::MoeOrder, true>(F.lds, g, S, E, F.wave);
#endif
    } SEAM(9);
    if (IN(10)) {
        FRESH();
        const int nblk = __builtin_amdgcn_readfirstlane(((const int*)(ws + WS_META))[0]);
#if MOE_FP8
        pg8::Gemm g{(const bf16*)(ws + WS_ACT), 256, 0, nullptr, (const bf16*)(ws + WS_MOEW0 + (size_t)NEXP * 1024 * 1024), (size_t)1024 * 256, 256, 256, 0}; pg8::MoeOrder S; S.init((const int*)(ws + WS_BLKE), nblk, F.G, (int)blockIdx.x);
        pg8::EpiDown8 E{(bf16*)(ws + WS_Y), (const float*)(ws + WS_WROW)};
        pg8::gemm_phase<pg8::EpiDown8, pg8::MoeOrder, false, true>(F.lds, g, S, E, F.wave);
#else
        pg8::Gemm g{(const bf16*)(ws + WS_ACT), FF, 0, nullptr, (const bf16*)(ws + WS_MOEW0) + (size_t)NEXP * 1024 * 1024, (size_t)1024 * 512, FF, FF, 0}; pg8::MoeOrder S; S.init((const int*)(ws + WS_BLKE), nblk, F.G, (int)blockIdx.x);
        pg8::EpiDown E{(bf16*)(ws + WS_Y), (const float*)(ws + WS_WROW)};
        pg8::gemm_phase<pg8::EpiDown, pg8::MoeOrder, false>(F.lds, g, S, E, F.wave);
#endif
    } SEAM(10);
    if (IN(11)) { FRESH(); phase_combine<false>(F, 0, (const bf16*)(ws + WS_X1), 0, 0, (const bf16*)(ws + WS_Y), (bf16*)(ws + WS_X2B), nullptr); } SEAM(11);
    if (IN(12)) {
        FRESH();
        pg8::Gemm g{(const bf16*)(ws + WS_H), D, 0, nullptr, (const bf16*)(ws + WS_WMIN), 0, D, D, 0}; pg8::DenseOrder S; S.init(T, 512, F.G, (int)blockIdx.x);
        pg8::EpiC E{(bf16*)(ws + WS_C), (float*)(ws + WS_SS4), (float*)(ws + WS_SSQ)};
        pg8::gemm_phase<pg8::EpiC, pg8::DenseOrder, false>(F.lds, g, S, E, F.wave);
    } SEAM(12);
    if (IN(13)) {
        FRESH();
        { pg8::Gemm g{(const bf16*)(ws + WS_C), 512, 256, nullptr, (const bf16*)(ws + WS_WKVB), 0, 128, 128, 0}; pg8::DenseOrder S; S.init(T, 1024, F.G, (int)blockIdx.x);
          { LAS float* rl_ = (LAS float*)(F.lds + RING_BYTES); for (int i = F.tid; i < 1024; i += NTHR) rl_[i] = ((const float*)(ws + WS_ROPE))[i]; __syncthreads(); }
          pg8::EpiKf E{(bf16*)(ws + WS_KF), (const bf16*)(ws + WS_C), (const float*)(ws + WS_SS4), F.a->in[I_MKQK], (const LAS float*)(F.lds + RING_BYTES)};
          pg8::gemm_phase<pg8::EpiKf, pg8::DenseOrder, false>(F.lds, g, S, E, F.wave); }
        __syncthreads();
        { pg8::Gemm g{(const bf16*)(ws + WS_WKVB) + (size_t)1024 * 128, 128, 0, nullptr, (const bf16*)(ws + WS_C), 0, 128, 512, 256}; pg8::DenseOrder S; S.init(1024, T, F.G, (int)blockIdx.x);
          pg8::EpiVt E{(bf16*)(ws + WS_VF), (const float*)(ws + WS_SS4)};
          pg8::gemm_phase<pg8::EpiVt, pg8::DenseOrder, false>(F.lds, g, S, E, F.wave);
#if defined(DUP_PHASE) && DUP_PHASE == 13
          __syncthreads(); pg8::gemm_phase<pg8::EpiVt, pg8::DenseOrder, false>(F.lds, g, S, E, F.wave);
#endif
#if defined(DUP_PHASE) && DUP_PHASE == 113
          __syncthreads(); pg8::gemm_phase<pg8::EpiVt, pg8::DenseOrder, false>(F.lds, g, S, E, F.wave); __syncthreads(); pg8::gemm_phase<pg8::EpiVt, pg8::DenseOrder, false>(F.lds, g, S, E, F.wave);
#endif
        }
    } SEAM(13);
    if (IN(15)) { FRESH();
#if ATT_FP8 == 2
        phase_attn8x2(F);
#else
        phase_attn(F);
#endif
#if defined(DUP_PHASE) && DUP_PHASE == 15
        __syncthreads(); phase_attn(F);
#endif
    } SEAM(15);
    if (IN(16)) {
        FRESH();
#if AO_FP8
        pg8::Gemm g{(const bf16*)(ws + WS_AO), 512, 0, nullptr, (const bf16*)(ws + WS_W4T), 0, 512, 512, 0}; pg8::DenseOrder S; S.init(TL, D, F.G, (int)blockIdx.x);
        pg8::EpiResid E{nullptr, nullptr, (const bf16*)(ws + WS_X2B), (bf16*)(ws + WS_X2B), mod1 + 2 * 1024, 1, 1.0f / 512.0f};
        pg8::gemm_phase<pg8::EpiResid, pg8::DenseOrder, false, true>(F.lds, g, S, E, F.wave);
#else
        pg8::Gemm g{(const bf16*)(ws + WS_AO), D, 0, nullptr, (const bf16*)(ws + WS_W4T), 0, D, D, 0}; pg8::DenseOrder S; S.init(TL, D, F.G, (int)blockIdx.x);
        pg8::EpiResid E{nullptr, nullptr, (const bf16*)(ws + WS_X2B), (bf16*)(ws + WS_X2B), mod1 + 2 * 1024, 1, 1.0f};
        pg8::gemm_phase<pg8::EpiResid, pg8::DenseOrder, false>(F.lds, g, S, E, F.wave);
#endif
    } SEAM(16);
    if (IN(17)) { FRESH();
#if MOE_FP8
        phase_ew2(F, 1, (const bf16*)(ws + WS_X2B), TC, TC, ws + WS_AO - (size_t)TC * D);
        if (ew_router_fused) { asm volatile("s_waitcnt vmcnt(0)" ::: "memory"); __syncthreads(); phase_router(F, 1, TC, TL / 256, (const bf16*)(ws + WS_X2B), TC); __syncthreads(); }
        moe_convert8(F, 1, ws + WS_MOEW1);
#else
        phase_ew2(F, 1, (const bf16*)(ws + WS_X2B), TC, TC, nullptr); moe_convert(F, 1, (bf16*)(ws + WS_MOEW1));
#endif
    }
    if (!ew_router_fused) { SEAM(17); if (IN(18)) { FRESH(); phase_router(F, 1, TC, TL / 256, (const bf16*)(ws + WS_X2B), TC); } }
    do { if (IN(18) && IN(19)) GRID_BAR(); } while (0);
    if (IN(19)) { FRESH(); phase_assign(F, TC, TL / 256); } SEAM(19);
    if (IN(20)) {
        FRESH();
        const int nblk = __builtin_amdgcn_readfirstlane(((const int*)(ws + WS_META))[0]);
#if MOE_FP8
        pg8::Gemm g{(const bf16*)(ws + WS_AO - (size_t)TC * D), 512, 0, (const int*)(ws + WS_TOKROW), (const bf16*)(ws + WS_MOEW1), (size_t)1024 * 512, 512, 512, 0}; pg8::MoeOrder S; S.init((const int*)(ws + WS_BLKE), nblk, F.G, (int)blockIdx.x);
        pg8::EpiSwiGLU8 E{ws + WS_ACT1};
        pg8::gemm_phase<pg8::EpiSwiGLU8, pg8::MoeOrder, true, true>(F.lds, g, S, E, F.wave);
#else
        pg8::Gemm g{(const bf16*)(ws + WS_H), D, 0, (const int*)(ws + WS_TOKROW), (const bf16*)(ws + WS_MOEW1), (size_t)1024 * 1024, D, D, 0}; pg8::MoeOrder S; S.init((const int*)(ws + WS_BLKE), nblk, F.G, (int)blockIdx.x);
        pg8::EpiSwiGLU E{(bf16*)(ws + WS_ACT1)};
        pg8::gemm_phase<pg8::EpiSwiGLU, pg8::MoeOrder, true>(F.lds, g, S, E, F.wave);
#endif
    } SEAM(20);
    if (IN(21)) {
        FRESH();
        const int nblk = __builtin_amdgcn_readfirstlane(((const int*)(ws + WS_META))[0]);
#if MOE_FP8
        pg8::Gemm g{(const bf16*)(ws + WS_ACT1), 256, 0, nullptr, (const bf16*)(ws + WS_MOEW1 + (size_t)NEXP * 1024 * 1024), (size_t)1024 * 256, 256, 256, 0}; pg8::MoeOrder S; S.init((const int*)(ws + WS_BLKE), nblk, F.G, (int)blockIdx.x);
        pg8::EpiDown8 E{(bf16*)(ws + WS_Y1), (const float*)(ws + WS_WROW)};
        pg8::gemm_phase<pg8::EpiDown8, pg8::MoeOrder, false, true>(F.lds, g, S, E, F.wave);
#else
        pg8::Gemm g{(const bf16*)(ws + WS_ACT1), FF, 0, nullptr, (const bf16*)(ws + WS_MOEW1) + (size_t)NEXP * 1024 * 1024, (size_t)1024 * 512, FF, FF, 0}; pg8::MoeOrder S; S.init((const int*)(ws + WS_BLKE), nblk, F.G, (int)blockIdx.x);
        pg8::EpiDown E{(bf16*)(ws + WS_Y1), (const float*)(ws + WS_WROW)};
        pg8::gemm_phase<pg8::EpiDown, pg8::MoeOrder, false>(F.lds, g, S, E, F.wave);
#endif
    } SEAM(21);
    if (IN(22)) { FRESH(); phase_combine<true>(F, 1, (const bf16*)(ws + WS_X2B), TC, TC, (const bf16*)(ws + WS_Y1), nullptr, outp); }
#undef IN
#undef SEAM
#undef FRESH
}

template <int PH> static bool setup_one() { return hipFuncSetAttribute((const void*)fwd_kernel<PH>, hipFuncAttributeMaxDynamicSharedMemorySize, LDS_BYTES) == hipSuccess; }
template <int PH> static void launch_one(int grid, hipStream_t stream, Args a) { a.ph_lo = PH; a.ph_hi = PH + 1; hipLaunchKernelGGL(fwd_kernel<PH>, dim3(grid), dim3(NTHR), LDS_BYTES, stream, a); }
extern "C" void kernel_launch(void* const* d_in, const int* in_sizes, int n_in, void* d_out, int out_size, void* d_ws, size_t ws_size, hipStream_t stream) {
    static int grid = 0;
    if (grid == 0) {
        if (n_in != 25 || out_size != TL * D || ws_size < WS_END) { fprintf(stderr, "kernel_launch: unexpected shapes (n_in %d out %d ws %zu)\n", n_in, out_size, ws_size); grid = -1; return; }
        int dev = 0, cus = 0;
        if (hipGetDevice(&dev) != hipSuccess || hipDeviceGetAttribute(&cus, hipDeviceAttributeMultiprocessorCount, dev) != hipSuccess) { grid = -1; return; }
        bool ok = true;
#if MK_N_LAUNCHES == 1
        ok = setup_one<-1>();
#else
        ok = ok && setup_one<0>() && setup_one<1>() && setup_one<2>() && setup_one<3>() && setup_one<4>() && setup_one<5>() && setup_one<6>() && setup_one<7>() && setup_one<8>() && setup_one<9>() && setup_one<10>() && setup_one<11>();
        ok = ok && setup_one<12>() && setup_one<13>() && setup_one<14>() && setup_one<15>() && setup_one<16>() && setup_one<17>() && setup_one<18>() && setup_one<19>() && setup_one<20>() && setup_one<21>() && setup_one<22>();
#endif
        if (!ok) { fprintf(stderr, "kernel_launch: hipFuncSetAttribute failed\n"); grid = -1; return; }
        (void)hipGetLastError();
        grid = cus;
        if (grid != 256) fprintf(stderr, "kernel_launch: %d CUs (built for 256)\n", grid);
    }
    if (grid < 0) return;
    (void)hipMemsetAsync((char*)d_ws + WS_CTL, 0, CTL_ZERO_BYTES, stream);
    Args a{};
    for (int i = 0; i < 25; ++i) a.in[i] = (const float*)d_in[i];
    a.out = (float*)d_out; a.ws = (unsigned char*)d_ws;
#if MK_N_LAUNCHES == 1
    a.ph_lo = 0; a.ph_hi = NPHASE;
    hipLaunchKernelGGL(fwd_kernel<-1>, dim3(grid), dim3(NTHR), LDS_BYTES, stream, a);
#else
    launch_one<0>(grid, stream, a); launch_one<1>(grid, stream, a); launch_one<2>(grid, stream, a); launch_one<3>(grid, stream, a); launch_one<4>(grid, stream, a); launch_one<5>(grid, stream, a);
    launch_one<6>(grid, stream, a); launch_one<7>(grid, stream, a); launch_one<8>(grid, stream, a); launch_one<9>(grid, stream, a); launch_one<10>(grid, stream, a); launch_one<11>(grid, stream, a);
    launch_one<12>(grid, stream, a); launch_one<13>(grid, stream, a); launch_one<14>(grid, stream, a); launch_one<15>(grid, stream, a); launch_one<16>(grid, stream, a); launch_one<17>(grid, stream, a);
    launch_one<18>(grid, stream, a); launch_one<19>(grid, stream, a); launch_one<20>(grid, stream, a); launch_one<21>(grid, stream, a); launch_one<22>(grid, stream, a);
#endif
}
```

```cpp
#include <hip/hip_runtime.h>
#include <cstdio>
#include <cstdint>

#ifndef MOE_FP8
#define MOE_FP8 1
#endif
#ifndef ATT_FP8
#define ATT_FP8 2
#ifndef HG_FP8
#define HG_FP8 1
#endif
#ifndef Y_FP8
#define Y_FP8 1
#endif
#ifndef Q_FP8
#define Q_FP8 1
#endif
#ifndef C_FP8
#define C_FP8 1
#endif
#ifndef AO_FP8
#define AO_FP8 1
#endif
#endif
#ifndef MK_N_LAUNCHES
#define MK_N_LAUNCHES 1
#endif

#define GAS __attribute__((address_space(1)))
#define LAS __attribute__((address_space(3)))
typedef unsigned short bf16;
typedef short bf16x8 __attribute__((ext_vector_type(8)));
typedef float f32x4 __attribute__((ext_vector_type(4)));
typedef float f32x16 __attribute__((ext_vector_type(16)));
typedef unsigned u32x4 __attribute__((ext_vector_type(4)));
typedef unsigned u32x2 __attribute__((ext_vector_type(2)));
typedef float f32x2_t __attribute__((ext_vector_type(2)));
typedef __bf16 bf16x2_t __attribute__((ext_vector_type(2)));

constexpr int D = 1024, NB = 32, SEQ = 2048, CTXL = 256;
constexpr int TC = NB * CTXL;
constexpr int TL = NB * SEQ;
constexpr int T = TC + TL;
constexpr int KVLEN = CTXL + SEQ;
constexpr int NH = 16, QK = 96, NOPE = 64, ROPE = 32, VD = 64;
constexpr int HGH = 8, HGD = 128;
constexpr int NEXP = 32, FF = 512;
constexpr float EPS = 1e-6f;
constexpr int MAXROWS = (2 * T / 256 + NEXP) * 256;
constexpr int NWAVES = 8, NTHR = 512;

constexpr size_t MiB = 1u << 20;
constexpr size_t WS_CTL = 0, CTL_ZERO_BYTES = 256 * 1024;
constexpr size_t WS_MOD = 1 * MiB;
constexpr size_t WS_LB = 3 * MiB;
constexpr size_t WS_ROPE = WS_LB + 16384;
constexpr size_t WS_META = WS_LB + 32768;
constexpr size_t WS_BLKE = WS_LB + 65536;
constexpr size_t WS_CNT = WS_LB + 131072;
constexpr size_t WS_RQ = 4 * MiB;
constexpr size_t WS_RKV = WS_RQ + 512 * 1024;
constexpr size_t WS_EID = 5 * MiB;
constexpr size_t WS_GW = WS_EID + 1 * MiB;
constexpr size_t WS_SLOT = WS_GW + 1 * MiB;
constexpr size_t WS_TOKROW = 8 * MiB;
constexpr size_t WS_WROW = 9 * MiB;
constexpr size_t WS_WR = 10 * MiB;
constexpr size_t WS_W1T = 11 * MiB;
constexpr size_t WS_W2T = 21 * MiB;
constexpr size_t WS_WMIN = 23 * MiB;
constexpr size_t WS_WQB = 24 * MiB;
constexpr size_t WS_WKVB = 25 * MiB;
constexpr size_t WS_W4T = 26 * MiB;
constexpr size_t WS_H = 32 * MiB;
constexpr size_t WS_BIG = 176 * MiB;
constexpr size_t WS_P = WS_BIG;
constexpr size_t WS_X1 = WS_BIG;
constexpr size_t WS_X2B = WS_BIG + 164 * MiB;
constexpr size_t WS_ACT = WS_BIG + 288 * MiB;
constexpr size_t WS_Y = WS_BIG + 440 * MiB;
constexpr size_t WS_MOEW0 = 928 * MiB;
constexpr size_t WS_WRP = 976 * MiB;
constexpr size_t WS_CB = 986 * MiB;
constexpr size_t WS_RMS = 987 * MiB;
constexpr size_t WS_END = 1024 * MiB;
constexpr size_t WS_C = WS_BIG;
constexpr size_t WS_QRAW = WS_BIG + 72 * MiB;
constexpr size_t WS_C8 = WS_BIG + 80 * MiB;
constexpr size_t WS_SSQ = WS_BIG + 76 * MiB;
constexpr size_t WS_SS4 = WS_BIG + 72 * MiB;
constexpr size_t WS_KVRAW = WS_BIG + 312 * MiB;
constexpr size_t WS_KF = WS_BIG + 600 * MiB;
constexpr size_t WS_VF = WS_H;
constexpr size_t WS_AO = WS_BIG + 312 * MiB;
#if MOE_FP8
constexpr size_t WS_MOEW1 = WS_MOEW0;
#else
constexpr size_t WS_MOEW1 = WS_BIG;
#endif
constexpr int MOE0_SPLIT = 20480;
constexpr int MOE1_SPLIT = C_FP8 ? 7680 : 13824;
constexpr size_t WS_ACT1 = WS_BIG + 96 * MiB;
constexpr size_t WS_Y1 = WS_BIG + 440 * MiB;
static_assert(WS_P + (size_t)T * 5120 * 2 <= WS_MOEW0, "P");
static_assert(WS_Y + (size_t)MAXROWS * 1024 * 2 <= WS_MOEW0, "Y");
static_assert(WS_KF + (size_t)NB * NH * KVLEN * QK * 2 <= WS_END, "KF");
static_assert(WS_KVRAW + (size_t)T * 2048 * 2 <= WS_KF, "KVRAW");
static_assert(WS_QRAW + (size_t)TL * 1536 * 2 <= WS_KVRAW, "QRAW");
static_assert(WS_W4T + 2 * MiB <= WS_H, "small weights");

constexpr int CW_BAR = 4096;

constexpr int RING_BYTES = 131072;
constexpr int MISC_OFF = 155648 - 512;
constexpr int LDS_BYTES = 155648;

__device__ __forceinline__ unsigned cvtpk(float lo, float hi) { f32x2_t v = {lo, hi}; bf16x2_t b = __builtin_convertvector(v, bf16x2_t); return __builtin_bit_cast(unsigned, b); }
__device__ __forceinline__ float bflo(unsigned u) { return __builtin_bit_cast(float, u << 16); }
__device__ __forceinline__ float bfhi(unsigned u) { return __builtin_bit_cast(float, u & 0xffff0000u); }
__device__ __forceinline__ float bf2f(bf16 h) { return __builtin_bit_cast(float, ((unsigned)h) << 16); }
__device__ __forceinline__ float wave_sum(float v) {
#pragma unroll
    for (int o = 1; o < 64; o <<= 1) v += __shfl_xor(v, o);
    return v;
}
__device__ __forceinline__ float half_sum(float v) {
#pragma unroll
    for (int o = 1; o < 32; o <<= 1) v += __shfl_xor(v, o);
    return v;
}
__device__ __forceinline__ float fast_exp(float x) { return __builtin_amdgcn_exp2f(x * 1.4426950408889634f); }
__device__ __forceinline__ float fast_rcp(float x) { return __builtin_amdgcn_rcpf(x); }
__device__ __forceinline__ float silu_f(float x) { return x * fast_rcp(1.0f + fast_exp(-x)); }
__device__ __forceinline__ unsigned pk4_fp8(float a, float b, float c, float d) { unsigned w; asm volatile("" : "=v"(w)); w = __builtin_amdgcn_cvt_pk_fp8_f32(a, b, w, false); w = __builtin_amdgcn_cvt_pk_fp8_f32(c, d, w, true); return w; }
#define LDS_WAIT() asm volatile("s_waitcnt lgkmcnt(0)" ::: "memory")
#define VM_WAIT() asm volatile("s_waitcnt vmcnt(0)" ::: "memory")

#define XB_TMO      128
#define XB_XCNT(j)  (256  + 64 * (j))
#define XB_XSUB(j)  (1280 + 64 * (j))
#define XB_XGEN(j)  (2304 + 64 * (j))
#define XB_TOP      3328
#define XB_TOPGEN   3392
#define XCD_BAR_WORDS 3456
#define XB_SPIN_CAP (1u << 18)
__device__ __forceinline__ unsigned xb_ld(unsigned* p)              { return __hip_atomic_load(p, __ATOMIC_RELAXED, __HIP_MEMORY_SCOPE_AGENT); }
__device__ __forceinline__ unsigned xb_add(unsigned* p, unsigned v) { return __hip_atomic_fetch_add(p, v, __ATOMIC_RELAXED, __HIP_MEMORY_SCOPE_AGENT); }
__device__ __forceinline__ unsigned xb_xcc_id() { return (unsigned)__builtin_amdgcn_s_getreg((3 << 11) | 20) & 0xFu; }
#define XB_SPIN(cond, bar) do { unsigned _sp = 0; while (cond) { __builtin_amdgcn_s_sleep(1); \
    if ((++_sp & 255u) == 0u) { if (xb_ld(&(bar)[XB_TMO])) break; if (_sp > XB_SPIN_CAP) { atomicAdd(&(bar)[XB_TMO], 1u); break; } } } } while (0)
struct XcdBarrier { unsigned* bar; unsigned x; volatile LAS unsigned* st; };
__device__ __forceinline__ XcdBarrier xcd_barrier_post(unsigned* bar, volatile LAS unsigned* st) {
    XcdBarrier b; b.bar = bar; b.x = xb_xcc_id(); b.st = st;
    if (threadIdx.x == 0) (void)xb_add(&bar[XB_XCNT(b.x)], 1u);
    return b;
}
__device__ __forceinline__ void xcd_barrier_complete(unsigned* bar, unsigned x, unsigned& nloc, unsigned& nx) {
    const unsigned G = gridDim.x * gridDim.y * gridDim.z;
    unsigned sum, cnt, mine, sp = 0u;
    for (;;) {
        sum = 0u; cnt = 0u; mine = 0u;
#pragma unroll
        for (unsigned j = 0; j < 16; ++j) { const unsigned c = xb_ld(&bar[XB_XCNT(j)]); sum += c; cnt += (c > 0u) ? 1u : 0u; mine = (j == x) ? c : mine; }
        if (sum == G) break;
        __builtin_amdgcn_s_sleep(1);
        if ((++sp & 255u) == 0u) { if (xb_ld(&bar[XB_TMO])) break; if (sp > XB_SPIN_CAP) { atomicAdd(&bar[XB_TMO], 1u); break; } }
    }
    nloc = mine > 0u ? mine : 1u; nx = cnt > 0u ? cnt : 1u;
}
__device__ __forceinline__ void xcd_barrier(const XcdBarrier& b) {
    asm volatile("s_waitcnt vmcnt(0)" ::: "memory");
    __syncthreads();
    if (threadIdx.x == 0) {
        unsigned* bar = b.bar;
        __builtin_amdgcn_s_waitcnt(0);
        unsigned nloc = b.st[0], nx = b.st[1];
        if (nloc == 0u) { xcd_barrier_complete(bar, b.x, nloc, nx); b.st[0] = nloc; b.st[1] = nx; }
        const unsigned old = xb_add(&bar[XB_XSUB(b.x)], 1u);
        const unsigned gen = old / nloc;
        if (old + 1u == (gen + 1u) * nloc) {
            __builtin_amdgcn_fence(__ATOMIC_RELEASE, "agent");
            asm volatile("s_waitcnt vmcnt(0)" ::: "memory");
            const unsigned og = xb_add(&bar[XB_TOP], 1u);
            const unsigned tg = og / nx;
            if (og + 1u == (tg + 1u) * nx) xb_add(&bar[XB_TOPGEN], 1u);
            else XB_SPIN(xb_ld(&bar[XB_TOPGEN]) == tg, bar);
            __builtin_amdgcn_fence(__ATOMIC_ACQUIRE, "agent");
            xb_add(&bar[XB_XGEN(b.x)], 1u);
            asm volatile("s_waitcnt vmcnt(0)" ::: "memory");
        } else {
            XB_SPIN(xb_ld(&bar[XB_XGEN(b.x)]) == gen, bar);
            __builtin_amdgcn_fence(__ATOMIC_ACQUIRE, "agent");
            asm volatile("s_waitcnt vmcnt(0)" ::: "memory");
        }
    }
    __syncthreads();
}

namespace pg8 {
constexpr int BM = 256, BK = 64, HALF = 128, HTB = HALF * BK * 2, STAGE_BYTES = 8 * HTB;
__host__ __device__ __forceinline__ int lds_byte(int r, int c) { const int st = (r >> 4) * 2 + (c >> 5), rr = r & 15, cc = c & 31, ob = rr * 64 + cc * 2; return st * 1024 + (ob ^ (((ob >> 9) & 1) << 5)); }
__host__ __device__ __forceinline__ void stage_rc(int b, int& R, int& C) { const int st = b / 1024, sb = b % 1024, swz = sb ^ (((sb >> 9) & 1) << 5); R = (st >> 1) * 16 + swz / 64; C = (st & 1) * 32 + (swz % 64) / 2; }
__host__ __device__ __forceinline__ int perm32(int rho) { const int n = rho >> 4, i = rho & 15; return 8 * (i >> 2) + 4 * n + (i & 3); }

struct Unit { int pm, pn, ex; };
struct Gemm { const bf16* A; int lda; int acol; const int* gather; const bf16* Bt; size_t bex; int K; int ldb; int bcol; };

struct DenseOrder {
    int nM, nN, nwg, G, c;
    __device__ __forceinline__ void init(int M, int N, int G_, int c_) { nM = M / BM; nN = N / BM; nwg = nM * nN; G = G_; c = c_; }
    __device__ __forceinline__ bool next(int i, Unit& u) const {
        const long L = (long)i * G + c; if (L >= nwg) return false;
        int wgid = (int)L; { const int q = nwg / 8, r = nwg % 8, xcd = wgid % 8, off = wgid / 8; wgid = (xcd < r ? xcd * (q + 1) : r * (q + 1) + (xcd - r) * q) + off; }
        const int nig = 8 * nN, gid = wgid / nig, fm = gid * 8, gsz = (nM - fm) < 8 ? (nM - fm) : 8;
        u.pm = fm + ((wgid % nig) % gsz); u.pn = (wgid % nig) / gsz; u.ex = 0; return true;
    }
};
struct MoeOrder {
    const int* blke; int nunits, G, vc;
    __device__ __forceinline__ void init(const int* blke_, int nblk, int G_, int c_) { blke = blke_; nunits = nblk * 4; G = G_; vc = (G_ % 8 == 0) ? (c_ % 8) * (G_ / 8) + c_ / 8 : c_; }
    __device__ __forceinline__ bool next(int i, Unit& u) const {
        const int L = i * G + vc; if (L >= nunits) return false;
        u.pm = L >> 2; u.pn = L & 3; u.ex = __builtin_amdgcn_readfirstlane(blke[u.pm]); return true;
    }
};

template <bool GATHER>
__device__ __forceinline__ void a_offsets(const Gemm& g, const Unit& u, const int (&R)[2], const int (&C)[2], unsigned (&vA)[2][2]) {
#pragma unroll
    for (int h = 0; h < 2; ++h)
#pragma unroll
        for (int i = 0; i < 2; ++i) { int row = u.pm * BM + h * HALF + R[i]; if (GATHER) row = g.gather[row]; vA[h][i] = (unsigned)(((size_t)row * g.lda + C[i]) * 2u); }
}

template <int N> __device__ __forceinline__ void wait_vm() { asm volatile("s_waitcnt vmcnt(%0)" :: "n"(N) : "memory"); }
template <class Epi, class Sched, bool GATHER, bool FP8 = false>
__device__ __forceinline__ void gemm_phase(LAS unsigned char* lds, const Gemm g, const Sched& S, const Epi& E, int wave_sgpr) {
    int tid_ = wave_sgpr * 64 + (int)__builtin_amdgcn_mbcnt_hi(~0u, __builtin_amdgcn_mbcnt_lo(~0u, 0u)); asm volatile("" : "+v"(tid_));
    const int tid = tid_, wid = __builtin_amdgcn_readfirstlane(tid >> 6), lane = tid & 63, wr = wid >> 2, wc = wid & 3, fr = lane & 15, fq = lane >> 4;
    int Kop_ = g.K; asm volatile("" : "+s"(Kop_));
    const int K = Kop_, nt = K / BK;
    int Rr[2], Cc[2]; unsigned voffB[2], voffA[2];
#pragma unroll
    for (int i = 0; i < 2; ++i) { int R, C; stage_rc(tid * 16 + i * 8192, R, C); const int Rb = Epi::ADJ ? (64 * (R >> 5) + perm32(R & 31)) : (Epi::PERM ? ((R & ~31) + perm32(R & 31)) : R); Rr[i] = R; Cc[i] = C; voffB[i] = (unsigned)(Rb * g.ldb + C) * 2u; voffA[i] = (unsigned)(R * g.lda + C) * 2u; }
    const size_t kstep = (size_t)(BK * 2);
    const size_t hstepB = (size_t)(Epi::ADJ ? 32 : HALF) * g.ldb * 2;
    const size_t hstepA = (size_t)HALF * g.lda * 2, tstepA = 2 * hstepA;
    const unsigned ldsw = (unsigned)wid * 1024u;
    const int aoff = lds_byte(wr * 64 + fr, fq * 8), boff = lds_byte(wc * 32 + fr, fq * 8);
#define PG8_SA(b, h) (((b) * 2 + (h)) * HTB)
#define PG8_SB(b, h) ((4 + (b) * 2 + (h)) * HTB)
#define PG8_STAGE_B(bufoff, gbase) do { _Pragma("unroll") for (int _i = 0; _i < 2; ++_i) \
        __builtin_amdgcn_global_load_lds((const unsigned*)((const char*)(gbase) + voffB[_i]), (LAS unsigned*)(lds + (bufoff) + ldsw + _i * 8192), 16, 0, 0); } while (0)
#define PG8_STAGE_A(bufoff, uptr, v0, v1) do { \
        __builtin_amdgcn_global_load_lds((const unsigned*)((uptr) + (v0)), (LAS unsigned*)(lds + (bufoff) + ldsw), 16, 0, 0); \
        __builtin_amdgcn_global_load_lds((const unsigned*)((uptr) + (v1)), (LAS unsigned*)(lds + (bufoff) + ldsw + 8192), 16, 0, 0); } while (0)
#define PG8_STAGE_A_CUR(bufoff, kb, h) do { if constexpr (GATHER) { PG8_STAGE_A(bufoff, Abase + (kb), vAc[h][0], vAc[h][1]); } else { PG8_STAGE_A(bufoff, cA + (kb) + (h) * hstepA, voffA[0], voffA[1]); } } while (0)
#define PG8_STAGE_A_NXT(bufoff, kb, h) do { if constexpr (GATHER) { PG8_STAGE_A(bufoff, Abase + (kb), ((h) ? w10 : w00), ((h) ? w11 : w01)); } else { PG8_STAGE_A(bufoff, a2 + (kb) + (h) * hstepA, voffA[0], voffA[1]); } } while (0)
#define PG8_LDA(dst, b, h) do { _Pragma("unroll") for (int m = 0; m < 4; ++m) { const v4i_ lo_ = *(const LAS v4i_*)(lds + PG8_SA(b, h) + aoff + m * 2048), hi_ = *(const LAS v4i_*)(lds + PG8_SA(b, h) + aoff + m * 2048 + 1024); dst[m] = __builtin_shufflevector(lo_, hi_, 0, 1, 2, 3, 4, 5, 6, 7); } } while (0)
#define PG8_LDB(dst, b, h) do { _Pragma("unroll") for (int n = 0; n < 2; ++n) { const v4i_ lo_ = *(const LAS v4i_*)(lds + PG8_SB(b, h) + boff + n * 2048), hi_ = *(const LAS v4i_*)(lds + PG8_SB(b, h) + boff + n * 2048 + 1024); dst[n] = __builtin_shufflevector(lo_, hi_, 0, 1, 2, 3, 4, 5, 6, 7); } } while (0)
#define PG8_K0(v) __builtin_bit_cast(bf16x8, __builtin_shufflevector(v, v, 0, 1, 2, 3))
#define PG8_K1(v) __builtin_bit_cast(bf16x8, __builtin_shufflevector(v, v, 4, 5, 6, 7))
#define PG8_MMA(ai, bj, At, Bt) do { __builtin_amdgcn_s_setprio(1); _Pragma("unroll") for (int m = 0; m < 4; ++m) _Pragma("unroll") for (int n = 0; n < 2; ++n) { \
        if constexpr (FP8) {   \
            asm volatile("v_mfma_scale_f32_16x16x128_f8f6f4 %0, %1, %2, %0, %3, %3 op_sel_hi:[0,0,0]" : "+v"(acc[ai][bj][m][n]) : "v"(Bt[n]), "v"(At[m]), "v"(one_scale)); } \
        else { acc[ai][bj][m][n] = __builtin_amdgcn_mfma_f32_16x16x32_bf16(PG8_K0(Bt[n]), PG8_K0(At[m]), acc[ai][bj][m][n], 0, 0, 0); acc[ai][bj][m][n] = __builtin_amdgcn_mfma_f32_16x16x32_bf16(PG8_K1(Bt[n]), PG8_K1(At[m]), acc[ai][bj][m][n], 0, 0, 0); } } \
        __builtin_amdgcn_s_setprio(0); } while (0)
#define PG8_WAIT_V(n) asm volatile("s_waitcnt vmcnt(" #n ")" ::: "memory")
#define PG8_WAIT_L(n) asm volatile("s_waitcnt lgkmcnt(" #n ")" ::: "memory")
#define PG8_BAR __builtin_amdgcn_s_barrier()
#define PG8_SCHED __builtin_amdgcn_sched_barrier(0)
    Unit cur, nxt; int ui = 0;
    if (!S.next(0, cur)) return;
    f32x4 acc[2][2][4][2];
#pragma unroll
    for (int a = 0; a < 2; ++a)
#pragma unroll
        for (int b = 0; b < 2; ++b)
#pragma unroll
            for (int m = 0; m < 4; ++m)
#pragma unroll
                for (int n = 0; n < 2; ++n) acc[a][b][m][n] = (f32x4){0.f, 0.f, 0.f, 0.f};
    typedef int v4i_ __attribute__((ext_vector_type(4))); typedef int v8i_ __attribute__((ext_vector_type(8)));
    v8i_ At[4], B0[2], B1[2];
    int one_scale = 0x7f7f7f7f; asm volatile("" : "+v"(one_scale));
    const char* Abase = (const char*)g.A + (size_t)g.acol * 2;
    const char* cA = Abase + (size_t)cur.pm * tstepA;
    unsigned vAc[2][2], vAn[2][2];
    if constexpr (GATHER) a_offsets<GATHER>(g, cur, Rr, Cc, vAc);
    const char* cB = (const char*)g.Bt + ((size_t)cur.ex * g.bex + (size_t)cur.pn * BM * g.ldb + g.bcol) * 2;
    PG8_STAGE_B(PG8_SB(0, 0), cB); PG8_STAGE_A_CUR(PG8_SA(0, 0), 0, 0); PG8_STAGE_B(PG8_SB(0, 1), cB + hstepB); PG8_STAGE_A_CUR(PG8_SA(0, 1), 0, 1);
    if (wr == 1) PG8_BAR;
    PG8_WAIT_V(4); PG8_BAR;
    PG8_STAGE_B(PG8_SB(1, 0), cB + kstep); PG8_STAGE_A_CUR(PG8_SA(1, 0), kstep, 0); PG8_STAGE_B(PG8_SB(1, 1), cB + hstepB + kstep);
    PG8_WAIT_V(6); PG8_BAR;
    for (;;) {
        const bool has_next = S.next(ui + 1, nxt);
        const char* nB = cB; const char* nA = cA;
        if (has_next) { if constexpr (GATHER) a_offsets<GATHER>(g, nxt, Rr, Cc, vAn); nA = Abase + (size_t)nxt.pm * tstepA; nB = (const char*)g.Bt + ((size_t)nxt.ex * g.bex + (size_t)nxt.pn * BM * g.ldb + g.bcol) * 2; }
        else if constexpr (GATHER) {
#pragma unroll
            for (int h = 0; h < 2; ++h)
#pragma unroll
                for (int i = 0; i < 2; ++i) vAn[h][i] = vAc[h][i];
        }
#pragma unroll 1
        for (int t = 0; t < nt; t += 2) {
            const bool last = (t == nt - 2);
            const size_t k1 = (size_t)(t + 1) * kstep;
            const size_t k2 = last ? (size_t)0 : (size_t)(t + 2) * kstep, k3 = k2 + kstep;
            unsigned w00 = 0, w01 = 0, w10 = 0, w11 = 0;
            if constexpr (GATHER) { w00 = last ? vAn[0][0] : vAc[0][0]; w01 = last ? vAn[0][1] : vAc[0][1]; w10 = last ? vAn[1][0] : vAc[1][0]; w11 = last ? vAn[1][1] : vAc[1][1]; }
            const char* a2 = last ? nA : cA;
            const char* b2 = last ? nB : cB + (size_t)(t + 2) * kstep; const char* b3 = b2 + kstep;
            (void)w00; (void)w01; (void)w10; (void)w11; (void)a2;
            PG8_LDB(B0, 0, 0); PG8_SCHED; PG8_LDA(At, 0, 0); PG8_STAGE_A_CUR(PG8_SA(1, 1), k1, 1);
            PG8_WAIT_L(8); PG8_BAR; PG8_WAIT_L(0); PG8_MMA(0, 0, At, B0); PG8_BAR; PG8_SCHED;
            PG8_LDB(B1, 0, 1); PG8_STAGE_B(PG8_SB(0, 0), b2);
            PG8_BAR; PG8_WAIT_L(0); PG8_MMA(0, 1, At, B1); PG8_BAR;
            PG8_LDA(At, 0, 1); PG8_STAGE_A_NXT(PG8_SA(0, 0), k2, 0);
            PG8_BAR; PG8_WAIT_L(0); PG8_MMA(1, 0, At, B0); PG8_BAR; PG8_SCHED;
            PG8_STAGE_B(PG8_SB(0, 1), b2 + hstepB);
            const bool after_epi = (Epi::NST > 0) && (t == 0) && (ui > 0);
            if (after_epi) wait_vm<8 + Epi::NST>(); else PG8_WAIT_V(6);
            PG8_BAR; PG8_MMA(1, 1, At, B1); PG8_BAR;
            PG8_LDB(B0, 1, 0); PG8_SCHED; PG8_LDA(At, 1, 0); PG8_STAGE_A_NXT(PG8_SA(0, 1), k2, 1);
            PG8_WAIT_L(8); PG8_BAR; PG8_WAIT_L(0); PG8_MMA(0, 0, At, B0); PG8_BAR; PG8_SCHED;
            PG8_LDB(B1, 1, 1); PG8_STAGE_B(PG8_SB(1, 0), b3);
            PG8_BAR; PG8_WAIT_L(0); PG8_MMA(0, 1, At, B1);
            if (after_epi) PG8_WAIT_V(10);
            PG8_BAR;
            PG8_LDA(At, 1, 1); PG8_STAGE_A_NXT(PG8_SA(1, 0), k3, 0);
            PG8_BAR; PG8_WAIT_L(0); PG8_MMA(1, 0, At, B0); PG8_BAR; PG8_SCHED;
            PG8_STAGE_B(PG8_SB(1, 1), b3 + hstepB);
            PG8_WAIT_V(6); PG8_BAR; PG8_MMA(1, 1, At, B1); PG8_BAR;
        }
        if (wr == 0) PG8_BAR;
        if constexpr (FP8) asm volatile("s_nop 15\n\ts_nop 15" ::: "memory");
        E(acc, cur, wr, wc, fr, fq);
        if (!has_next) break;
#pragma unroll
        for (int a = 0; a < 2; ++a)
#pragma unroll
            for (int b = 0; b < 2; ++b)
#pragma unroll
                for (int m = 0; m < 4; ++m)
#pragma unroll
                    for (int n = 0; n < 2; ++n) acc[a][b][m][n] = (f32x4){0.f, 0.f, 0.f, 0.f};
        cur = nxt; cB = nB; cA = nA; ++ui;
        if (wr == 1) PG8_BAR;
        if constexpr (GATHER) {
#pragma unroll
            for (int h = 0; h < 2; ++h)
#pragma unroll
                for (int i = 0; i < 2; ++i) vAc[h][i] = vAn[h][i];
        }
    }
    PG8_WAIT_V(0);
    PG8_BAR;
#undef PG8_SA
#undef PG8_SB
#undef PG8_STAGE_A
#undef PG8_STAGE_A_CUR
#undef PG8_STAGE_A_NXT
#undef PG8_STAGE_B
#undef PG8_LDA
#undef PG8_LDB
#undef PG8_MMA
#undef PG8_K0
#undef PG8_K1
#undef PG8_WAIT_V
#undef PG8_WAIT_L
#undef PG8_BAR
#undef PG8_SCHED
}

struct EpiBf16Plain {
    static constexpr bool PERM = true; static constexpr bool ADJ = false; static constexpr int NST = 16;
    bf16* O; int ldc;
    __device__ __forceinline__ void operator()(const f32x4 (&acc)[2][2][4][2], const Unit& u, int wr, int wc, int fr, int fq) const {
        asm volatile("" : "+v"(fr), "+v"(fq));
        const int row0 = u.pm * BM + wr * 64 + fr, col0 = u.pn * BM + wc * 32 + 8 * fq;
#pragma unroll
        for (int ai = 0; ai < 2; ++ai)
#pragma unroll
            for (int m = 0; m < 4; ++m) { bf16* rowp = O + (size_t)(row0 + ai * HALF + m * 16) * ldc + col0;
#pragma unroll
                for (int bj = 0; bj < 2; ++bj) { const f32x4 v0 = acc[ai][bj][m][0], v1 = acc[ai][bj][m][1];
                    u32x4 w; w.x = cvtpk(v0[0], v0[1]); w.y = cvtpk(v0[2], v0[3]); w.z = cvtpk(v1[0], v1[1]); w.w = cvtpk(v1[2], v1[3]);
                    *(u32x4*)(rowp + bj * HALF) = w; } }
    }
};
struct EpiHgIn {
    static constexpr bool PERM = true; static constexpr bool ADJ = true;  static constexpr int NST = 16;
    bf16* O; const float* lb;
    __device__ __forceinline__ void operator()(const f32x4 (&acc)[2][2][4][2], const Unit& u, int wr, int wc, int fr, int fq) const {
        asm volatile("" : "+v"(fr), "+v"(fq));
        const int row0 = u.pm * BM + wr * 64 + fr, col0 = u.pn * BM + wc * 64 + 8 * fq;
        const int typ = u.pn >> 2;
        float lbv[2][8];
#pragma unroll
        for (int bj = 0; bj < 2; ++bj)
#pragma unroll
            for (int j = 0; j < 8; ++j) lbv[bj][j] = (typ == 1 || typ == 2) ? lb[(typ - 1) * 1024 + ((col0 + bj * 32 + j) & 1023)] : 0.f;
#pragma unroll
        for (int ai = 0; ai < 2; ++ai)
#pragma unroll
            for (int m = 0; m < 4; ++m) { bf16* rowp = O + (size_t)(row0 + ai * HALF + m * 16) * 5120 + col0;
#pragma unroll
                for (int bj = 0; bj < 2; ++bj) { float x[8];
#pragma unroll
                    for (int j = 0; j < 4; ++j) { x[j] = acc[ai][bj][m][0][j]; x[4 + j] = acc[ai][bj][m][1][j]; }
                    if (typ == 0) {
#pragma unroll
                        for (int j = 0; j < 8; ++j) x[j] = silu_f(x[j]);
                    } else if (typ == 1 || typ == 2) {
#pragma unroll
                        for (int j = 0; j < 8; ++j) { const float sg = fast_rcp(1.0f + fast_exp(-x[j])); const float f = lbv[bj][j] + (1.0f - lbv[bj][j]) * sg; x[j] = f; }
                    }
                    u32x4 w; w.x = cvtpk(x[0], x[1]); w.y = cvtpk(x[2], x[3]); w.z = cvtpk(x[4], x[5]); w.w = cvtpk(x[6], x[7]);
                    __builtin_nontemporal_store(w, (u32x4*)(rowp + bj * 32)); } }
    }
};
struct EpiResid {
    static constexpr bool PERM = true; static constexpr bool ADJ = true;  static constexpr int NST = 8;
    const float* base_ctx; const float* base_lat; const bf16* base16; bf16* out; const float* mod; int lat_only; float ascale;
    __device__ __forceinline__ void operator()(const f32x4 (&acc)[2][2][4][2], const Unit& u, int wr, int wc, int fr, int fq) const {
        asm volatile("" : "+v"(fr), "+v"(fq));
        int bidx; size_t srow0, drow0;
        if (lat_only) { bidx = u.pm >> 3; srow0 = (size_t)u.pm * BM; drow0 = srow0; }
        else if (u.pm < 32) { bidx = 32; srow0 = (size_t)u.pm * BM; drow0 = srow0; }
        else { bidx = (u.pm - 32) >> 3; srow0 = (size_t)(u.pm - 32) * BM; drow0 = (size_t)u.pm * BM; }
        const float* src = (!lat_only && u.pm < 32) ? base_ctx : base_lat;
        const float* gt = mod + (size_t)bidx * 6144;
        const int rl0 = wr * 64 + fr, col0 = u.pn * BM + wc * 64 + 8 * fq;
        f32x4 gate[2][2];
#pragma unroll
        for (int bj = 0; bj < 2; ++bj) { const int col = col0 + bj * 32; gate[bj][0] = *(const f32x4*)(gt + col) * ascale; gate[bj][1] = *(const f32x4*)(gt + col + 4) * ascale; }
        if (base16) {
            u32x4 bw[2][4][2];
#pragma unroll
            for (int ai = 0; ai < 2; ++ai)
#pragma unroll
                for (int m = 0; m < 4; ++m)
#pragma unroll
                    for (int bj = 0; bj < 2; ++bj) bw[ai][m][bj] = *(const u32x4*)(base16 + (srow0 + rl0 + ai * HALF + m * 16) * D + col0 + bj * 32);
#pragma unroll
            for (int ai = 0; ai < 2; ++ai)
#pragma unroll
                for (int m = 0; m < 4; ++m) { const int rl = rl0 + ai * HALF + m * 16;
#pragma unroll
                    for (int bj = 0; bj < 2; ++bj) { const u32x4 w0 = bw[ai][m][bj];
                        const f32x4 b0 = (f32x4){bflo(w0.x), bfhi(w0.x), bflo(w0.y), bfhi(w0.y)}, b1 = (f32x4){bflo(w0.z), bfhi(w0.z), bflo(w0.w), bfhi(w0.w)};
                        const f32x4 v0 = b0 + gate[bj][0] * acc[ai][bj][m][0], v1 = b1 + gate[bj][1] * acc[ai][bj][m][1];
                        u32x4 w; w.x = cvtpk(v0[0], v0[1]); w.y = cvtpk(v0[2], v0[3]); w.z = cvtpk(v1[0], v1[1]); w.w = cvtpk(v1[2], v1[3]);
                        *(u32x4*)(out + (drow0 + rl) * D + col0 + bj * 32) = w; } }
        } else {
#pragma unroll
            for (int ai = 0; ai < 2; ++ai) {
                f32x4 bb[4][2][2];
#pragma unroll
                for (int m = 0; m < 4; ++m)
#pragma unroll
                    for (int bj = 0; bj < 2; ++bj) { const float* sp = src + (srow0 + rl0 + ai * HALF + m * 16) * D + col0 + bj * 32; bb[m][bj][0] = __builtin_nontemporal_load((const f32x4*)sp); bb[m][bj][1] = __builtin_nontemporal_load((const f32x4*)(sp + 4)); }
#pragma unroll
                for (int m = 0; m < 4; ++m) { const int rl = rl0 + ai * HALF + m * 16;
#pragma unroll
                    for (int bj = 0; bj < 2; ++bj) { const f32x4 v0 = bb[m][bj][0] + gate[bj][0] * acc[ai][bj][m][0], v1 = bb[m][bj][1] + gate[bj][1] * acc[ai][bj][m][1];
                        u32x4 w; w.x = cvtpk(v0[0], v0[1]); w.y = cvtpk(v0[2], v0[3]); w.z = cvtpk(v1[0], v1[1]); w.w = cvtpk(v1[2], v1[3]);
                        *(u32x4*)(out + (drow0 + rl) * D + col0 + bj * 32) = w; } }
                asm volatile("" ::: "memory"); }
        }
    }
};
struct EpiSwiGLU {
    static constexpr bool PERM = true; static constexpr bool ADJ = false; static constexpr int NST = 8;
    bf16* O;
    __device__ __forceinline__ void operator()(const f32x4 (&acc)[2][2][4][2], const Unit& u, int wr, int wc, int fr, int fq) const {
        asm volatile("" : "+v"(fr), "+v"(fq));
        const int row0 = u.pm * BM + wr * 64 + fr, col0 = u.pn * 128 + wc * 32 + 8 * fq;
#pragma unroll
        for (int ai = 0; ai < 2; ++ai)
#pragma unroll
            for (int m = 0; m < 4; ++m) { bf16* rowp = O + (size_t)(row0 + ai * HALF + m * 16) * FF + col0; float x[8];
#pragma unroll
                for (int n = 0; n < 2; ++n)
#pragma unroll
                    for (int j = 0; j < 4; ++j) x[n * 4 + j] = silu_f(acc[ai][0][m][n][j]) * acc[ai][1][m][n][j];
                u32x4 w; w.x = cvtpk(x[0], x[1]); w.y = cvtpk(x[2], x[3]); w.z = cvtpk(x[4], x[5]); w.w = cvtpk(x[6], x[7]);
                *(u32x4*)rowp = w; }
    }
};
struct EpiDown {
    static constexpr bool PERM = true; static constexpr bool ADJ = false; static constexpr int NST = 16;
    bf16* O; const float* wrow;
    __device__ __forceinline__ void operator()(const f32x4 (&acc)[2][2][4][2], const Unit& u, int wr, int wc, int fr, int fq) const {
        asm volatile("" : "+v"(fr), "+v"(fq));
        const int row0 = u.pm * BM + wr * 64 + fr, col0 = u.pn * BM + wc * 32 + 8 * fq;
#pragma unroll
        for (int ai = 0; ai < 2; ++ai)
#pragma unroll
            for (int m = 0; m < 4; ++m) { const int row = row0 + ai * HALF + m * 16; const float s = wrow[row]; bf16* rowp = O + (size_t)row * D + col0;
#pragma unroll
                for (int bj = 0; bj < 2; ++bj) { const f32x4 v0 = acc[ai][bj][m][0] * s, v1 = acc[ai][bj][m][1] * s;
                    u32x4 w; w.x = cvtpk(v0[0], v0[1]); w.y = cvtpk(v0[2], v0[3]); w.z = cvtpk(v1[0], v1[1]); w.w = cvtpk(v1[2], v1[3]);
                    *(u32x4*)(rowp + bj * HALF) = w; } }
    }
};
struct EpiC {
    static constexpr bool PERM = true; static constexpr bool ADJ = true;  static constexpr int NST = 16;
    bf16* O; float* ss4; float* ssq; unsigned char* c8;
    __device__ __forceinline__ void operator()(const f32x4 (&acc)[2][2][4][2], const Unit& u, int wr, int wc, int fr, int fq) const {
        { int ln_ = (int)__builtin_amdgcn_mbcnt_hi(~0u, __builtin_amdgcn_mbcnt_lo(~0u, 0u)); asm volatile("" : "+v"(ln_)); fr = ln_ & 15; fq = ln_ >> 4; }
        constexpr float ascale = C_FP8 ? 1.0f / 32.0f : 1.0f;
        const int row0 = u.pm * BM + wr * 64 + fr, col0 = u.pn * BM + wc * 64 + 8 * fq;
#pragma unroll
        for (int ai = 0; ai < 2; ++ai)
#pragma unroll
            for (int m = 0; m < 4; ++m) { const int row = row0 + ai * HALF + m * 16; bf16* rowp = O + (size_t)row * 512 + col0;
#pragma unroll
                for (int bj = 0; bj < 2; ++bj) { const f32x4 v0 = acc[ai][bj][m][0] * ascale, v1 = acc[ai][bj][m][1] * ascale;
                    u32x4 w; w.x = cvtpk(v0[0], v0[1]); w.y = cvtpk(v0[2], v0[3]); w.z = cvtpk(v1[0], v1[1]); w.w = cvtpk(v1[2], v1[3]);
                    if (!(Q_FP8 && u.pn == 0)) *(u32x4*)(rowp + bj * 32) = w;
                    if (Q_FP8 && u.pn == 0) { u32x2 w8; w8.x = pk4_fp8(v0[0] * 16.0f, v0[1] * 16.0f, v0[2] * 16.0f, v0[3] * 16.0f); w8.y = pk4_fp8(v1[0] * 16.0f, v1[1] * 16.0f, v1[2] * 16.0f, v1[3] * 16.0f);
                        int rq_ = row; asm volatile("" : "+v"(rq_));
                        *(u32x2*)(c8 + (size_t)rq_ * 256 + wc * 64 + 8 * fq + bj * 32) = w8; } }
                if (u.pn == 1) { float q = 0.f;
#pragma unroll
                    for (int bj = 0; bj < 2; ++bj) { const f32x4 v0 = acc[ai][bj][m][0] * ascale, v1 = acc[ai][bj][m][1] * ascale; q += (v0[0] * v0[0] + v0[1] * v0[1]) + (v0[2] * v0[2] + v0[3] * v0[3]) + (v1[0] * v1[0] + v1[1] * v1[1]) + (v1[2] * v1[2] + v1[3] * v1[3]); }
                    q += __shfl_xor(q, 16); q += __shfl_xor(q, 32);
                    if (fq == 0) ss4[(size_t)row * 4 + wc] = (wc < 2) ? q : 0.f; }
                else { float q = 0.f;
#pragma unroll
                    for (int bj = 0; bj < 2; ++bj) { const f32x4 v0 = acc[ai][bj][m][0] * ascale, v1 = acc[ai][bj][m][1] * ascale; q += (v0[0] * v0[0] + v0[1] * v0[1]) + (v0[2] * v0[2] + v0[3] * v0[3]) + (v1[0] * v1[0] + v1[1] * v1[1]) + (v1[2] * v1[2] + v1[3] * v1[3]); }
                    q += __shfl_xor(q, 16); q += __shfl_xor(q, 32);
                    if (fq == 0) ssq[(size_t)row * 4 + wc] = q; }
                asm volatile("" ::: "memory"); }
    }
};
struct EpiKf {
    static constexpr bool PERM = true; static constexpr bool ADJ = false; static constexpr int NST = 8;
    bf16* Kf; const bf16* C; const float* ss4; const float* gk; const LAS float* ropel; LAS unsigned char* xl;
    __device__ __forceinline__ void operator()(const f32x4 (&acc)[2][2][4][2], const Unit& u, int wr, int wc, int fr, int fq) const {
        asm volatile("" : "+v"(fr), "+v"(fq));
        const int h = 4 * u.pn + wc;
        int b, pos0; if (u.pm < 32) { b = u.pm; pos0 = 0; } else { b = (u.pm - 32) >> 3; pos0 = CTXL + ((u.pm - 32) & 7) * 256; }
        float g0[8], g1[8], gr[8];
#pragma unroll
        for (int j = 0; j < 8; ++j) { g0[j] = gk[8 * fq + j]; g1[j] = gk[32 + 8 * fq + j]; gr[j] = gk[64 + 8 * fq + j]; }
        const int ax = fq >> 1, odd = fq & 1;
#pragma unroll
        for (int ai = 0; ai < 2; ++ai) {
            float rkv4[4]; u32x4 rw4[4];
#pragma unroll
            for (int m = 0; m < 4; ++m) { const int row = u.pm * BM + ai * HALF + wr * 64 + m * 16 + fr;
                const f32x4 s4 = *(const f32x4*)(ss4 + (size_t)row * 4); rkv4[m] = 1.0f / sqrtf(((s4.x + s4.y) + (s4.z + s4.w)) * (1.0f / 128.0f) + EPS);
                rw4[m] = *(const u32x4*)(C + (size_t)row * 512 + 384 + 8 * fq); }
#pragma unroll
            for (int m = 0; m < 4; ++m) { const int rl = ai * HALF + wr * 64 + m * 16 + fr; const int pos = pos0 + rl;
                const float rkv = rkv4[m]; const u32x4 rw = rw4[m];
                float kn[16], kr[8];
#pragma unroll
                for (int bj = 0; bj < 2; ++bj)
#pragma unroll
                    for (int j = 0; j < 4; ++j) { kn[8 * bj + j] = acc[ai][bj][m][0][j] * rkv; kn[8 * bj + 4 + j] = acc[ai][bj][m][1][j] * rkv; }
#pragma unroll
                for (int j = 0; j < 4; ++j) { kr[2 * j] = bflo(rw[j]); kr[2 * j + 1] = bfhi(rw[j]); }
                float ss = 0.f;
#pragma unroll
                for (int j = 0; j < 16; ++j) ss += kn[j] * kn[j];
#pragma unroll
                for (int j = 0; j < 8; ++j) ss += kr[j] * kr[j];
                ss += __shfl_xor(ss, 16); ss += __shfl_xor(ss, 32);
                const float rn = 1.0f / sqrtf(ss * (1.0f / 96.0f) + EPS);
#if ATT_FP8
                LAS unsigned char* kd8 = xl + (wr * 4 + wc) * 2304 + fr * 144 + 32 * (fq & 1) + 8 * (fq >> 1);
                { u32x2 w; w.x = pk4_fp8(kn[0] * rn * g0[0], kn[1] * rn * g0[1], kn[2] * rn * g0[2], kn[3] * rn * g0[3]); w.y = pk4_fp8(kn[4] * rn * g0[4], kn[5] * rn * g0[5], kn[6] * rn * g0[6], kn[7] * rn * g0[7]); *(LAS u32x2*)kd8 = w;
                  w.x = pk4_fp8(kn[8] * rn * g1[0], kn[9] * rn * g1[1], kn[10] * rn * g1[2], kn[11] * rn * g1[3]); w.y = pk4_fp8(kn[12] * rn * g1[4], kn[13] * rn * g1[5], kn[14] * rn * g1[6], kn[15] * rn * g1[7]); *(LAS u32x2*)(kd8 + 16) = w;
                  *(LAS u32x2*)(kd8 + 80) = (u32x2){0u, 0u}; }
#else
                bf16* kd = Kf + ((size_t)(b * NH + h) * KVLEN + pos) * QK;
                { u32x4 w; w.x = cvtpk(kn[0] * rn * g0[0], kn[1] * rn * g0[1]); w.y = cvtpk(kn[2] * rn * g0[2], kn[3] * rn * g0[3]); w.z = cvtpk(kn[4] * rn * g0[4], kn[5] * rn * g0[5]); w.w = cvtpk(kn[6] * rn * g0[6], kn[7] * rn * g0[7]); *(u32x4*)(kd + 8 * fq) = w;
                  w.x = cvtpk(kn[8] * rn * g1[0], kn[9] * rn * g1[1]); w.y = cvtpk(kn[10] * rn * g1[2], kn[11] * rn * g1[3]); w.z = cvtpk(kn[12] * rn * g1[4], kn[13] * rn * g1[5]); w.w = cvtpk(kn[14] * rn * g1[6], kn[15] * rn * g1[7]); *(u32x4*)(kd + 32 + 8 * fq) = w; }
#endif
                float o8[8];
                const int t = pos - CTXL; const int p = ax ? (t & 63) : (t >> 6);
#pragma unroll
                for (int i = 0; i < 8; ++i) { const float mine = kr[i] * rn * gr[i]; const float other = __shfl_xor(mine, 16);
                    float cs = 1.f, sn = 0.f; if (u.pm >= 32) { const f32x2_t csn = *(const LAS f32x2_t*)(ropel + (p * 8 + i) * 2); cs = csn.x; sn = csn.y; }
                    o8[i] = mine * cs + (odd ? other : -other) * sn; }
#if ATT_FP8
                { u32x2 w; w.x = pk4_fp8(o8[0], o8[1], o8[2], o8[3]); w.y = pk4_fp8(o8[4], o8[5], o8[6], o8[7]); *(LAS u32x2*)(kd8 + 64) = w; }
                { const LAS unsigned char* rd = xl + (wr * 4 + wc) * 2304 + fr * 144 + 32 * fq; const u32x4 r0 = *(const LAS u32x4*)rd, r1 = *(const LAS u32x4*)(rd + 16);
                  unsigned char* kg = (unsigned char*)Kf + ((size_t)(b * NH + h) * KVLEN + pos) * 128 + 32 * fq; *(u32x4*)kg = r0; *(u32x4*)(kg + 16) = r1; }
#else
                { u32x4 w; w.x = cvtpk(o8[0], o8[1]); w.y = cvtpk(o8[2], o8[3]); w.z = cvtpk(o8[4], o8[5]); w.w = cvtpk(o8[6], o8[7]); *(u32x4*)(kd + 64 + 8 * fq) = w; }
#endif
                asm volatile("" ::: "memory"); } }
    }
};
#if ATT_FP8
struct EpiVt {
    static constexpr bool PERM = true; static constexpr bool ADJ = true; static constexpr int NST = 8;
    bf16* Vt; const float* ss4; LAS unsigned char* xl;
    __device__ __forceinline__ void operator()(const f32x4 (&acc)[2][2][4][2], const Unit& u, int wr, int wc, int fr, int fq) const {
        asm volatile("" : "+v"(fr), "+v"(fq));
        int b, pos0; if (u.pn < 32) { b = u.pn; pos0 = 0; } else { b = (u.pn - 32) >> 3; pos0 = CTXL + ((u.pn - 32) & 7) * 256; }
        float rk2[2][8];
#pragma unroll
        for (int bj = 0; bj < 2; ++bj) { const int cl = 64 * wc + 32 * bj + 8 * fq;
#pragma unroll
            for (int j = 0; j < 8; ++j) { const f32x4 s4 = *(const f32x4*)(ss4 + (size_t)(u.pn * BM + cl + j) * 4); rk2[bj][j] = 1.0f / sqrtf(((s4.x + s4.y) + (s4.z + s4.w)) * (1.0f / 128.0f) + EPS); }
            asm volatile("" ::: "memory"); }
        LAS unsigned char* xw = xl + (wr * 4 + wc) * 1280 + fr * 80;
#pragma unroll
        for (int ai = 0; ai < 2; ++ai)
#pragma unroll
            for (int m = 0; m < 4; ++m) {
#pragma unroll
                for (int bj = 0; bj < 2; ++bj)
#pragma unroll
                    for (int n = 0; n < 2; ++n) { const f32x4 v = acc[ai][bj][m][n];
                        *(LAS unsigned*)(xw + 16 * (2 * n + bj) + 4 * fq) = pk4_fp8(v[0] * rk2[bj][4 * n], v[1] * rk2[bj][4 * n + 1], v[2] * rk2[bj][4 * n + 2], v[3] * rk2[bj][4 * n + 3]); }
                const u32x4 row16 = *(const LAS u32x4*)(xw + 16 * fq);
                const int r = u.pm * BM + ai * HALF + wr * 64 + m * 16 + fr; const int h = r >> 6, d = r & 63;
                *(u32x4*)((unsigned char*)Vt + ((size_t)(b * NH + h) * VD + d) * KVLEN + pos0 + 64 * wc + 16 * fq) = row16; }
    }
};
#else
struct EpiVt {
    static constexpr bool PERM = true; static constexpr bool ADJ = false; static constexpr int NST = 32;
    bf16* Vt; const float* ss4;
    __device__ __forceinline__ void operator()(const f32x4 (&acc)[2][2][4][2], const Unit& u, int wr, int wc, int fr, int fq) const {
        asm volatile("" : "+v"(fr), "+v"(fq));
        int b, pos0; if (u.pn < 32) { b = u.pn; pos0 = 0; } else { b = (u.pn - 32) >> 3; pos0 = CTXL + ((u.pn - 32) & 7) * 256; }
        const int m8 = 16 * 0;  (void)m8;
        float rk2[2][8];
#pragma unroll
        for (int bj = 0; bj < 2; ++bj) { const int cl = bj * HALF + wc * 32 + 8 * fq;
#pragma unroll
            for (int j = 0; j < 8; ++j) { const f32x4 s4 = *(const f32x4*)(ss4 + (size_t)(u.pn * BM + cl + j) * 4); rk2[bj][j] = 1.0f / sqrtf(((s4.x + s4.y) + (s4.z + s4.w)) * (1.0f / 128.0f) + EPS); }
            asm volatile("" ::: "memory"); }
#pragma unroll
        for (int bj = 0; bj < 2; ++bj) { const int cl = bj * HALF + wc * 32 + 8 * fq;
            float rk[8];
#pragma unroll
            for (int j = 0; j < 8; ++j) rk[j] = rk2[bj][j];
            const int pos = pos0 + cl;
#if ATT_FP8
            const int ub = (pos & ~63) + 16 * ((pos >> 5) & 1) + 4 * ((pos >> 3) & 3);
#pragma unroll
            for (int ai = 0; ai < 2; ++ai)
#pragma unroll
                for (int m = 0; m < 4; ++m) { const int r = u.pm * BM + ai * HALF + wr * 64 + m * 16 + fr; const int h = r >> 6, d = r & 63;
                    unsigned char* vd = (unsigned char*)Vt + ((size_t)(b * NH + h) * VD + d) * KVLEN + ub;
                    const f32x4 v0 = acc[ai][bj][m][0], v1 = acc[ai][bj][m][1];
                    *(unsigned*)vd = pk4_fp8(v0[0] * rk[0], v0[1] * rk[1], v0[2] * rk[2], v0[3] * rk[3]); *(unsigned*)(vd + 32) = pk4_fp8(v1[0] * rk[4], v1[1] * rk[5], v1[2] * rk[6], v1[3] * rk[7]); }
#else
            const int e = (pos >> 3) & 1;
            const int ub = (pos & ~15) + 4 * e;
#pragma unroll
            for (int ai = 0; ai < 2; ++ai)
#pragma unroll
                for (int m = 0; m < 4; ++m) { const int r = u.pm * BM + ai * HALF + wr * 64 + m * 16 + fr; const int h = r >> 6, d = r & 63;
                    bf16* vd = Vt + ((size_t)(b * NH + h) * VD + d) * KVLEN + ub;
                    const f32x4 v0 = acc[ai][bj][m][0], v1 = acc[ai][bj][m][1];
                    u32x2 w0, w1; w0.x = cvtpk(v0[0] * rk[0], v0[1] * rk[1]); w0.y = cvtpk(v0[2] * rk[2], v0[3] * rk[3]); w1.x = cvtpk(v1[0] * rk[4], v1[1] * rk[5]); w1.y = cvtpk(v1[2] * rk[6], v1[3] * rk[7]);
                    *(u32x2*)vd = w0; *(u32x2*)(vd + 8) = w1; }
#endif
            asm volatile("" ::: "memory"); }
    }
};
#endif
struct EpiSwiGLU8 {
    static constexpr bool PERM = true; static constexpr bool ADJ = false; static constexpr int NST = 8;
    unsigned char* O;
    __device__ __forceinline__ void operator()(const f32x4 (&acc)[2][2][4][2], const Unit& u, int wr, int wc, int fr, int fq) const {
        asm volatile("" : "+v"(fr), "+v"(fq));
        const int row0 = u.pm * BM + wr * 64 + fr, col0 = u.pn * 128 + wc * 32 + 8 * fq;
#pragma unroll
        for (int ai = 0; ai < 2; ++ai)
#pragma unroll
            for (int m = 0; m < 4; ++m) { unsigned char* rowp = O + (size_t)(row0 + ai * HALF + m * 16) * FF + col0; float x[8];
#pragma unroll
                for (int n = 0; n < 2; ++n)
#pragma unroll
                    for (int j = 0; j < 4; ++j) x[n * 4 + j] = silu_f(acc[ai][0][m][n][j] * 0.03125f) * (acc[ai][1][m][n][j] * 0.03125f);
                u32x2 w; w.x = pk4_fp8(x[0], x[1], x[2], x[3]); w.y = pk4_fp8(x[4], x[5], x[6], x[7]);
                *(u32x2*)rowp = w; }
    }
};
struct EpiDown8 {
    static constexpr bool PERM = true; static constexpr bool ADJ = true;  static constexpr int NST = Y_FP8 ? 8 : 16;
    bf16* O; const float* wrow; LAS unsigned char* xl;
    __device__ __forceinline__ void operator()(const f32x4 (&acc)[2][2][4][2], const Unit& u, int wr, int wc, int fr, int fq) const {
        asm volatile("" : "+v"(fr), "+v"(fq));
        const int row0 = u.pm * BM + wr * 64 + fr, col0 = u.pn * BM + wc * 64 + 8 * fq;
        float sv[8];
#pragma unroll
        for (int i = 0; i < 8; ++i) sv[i] = wrow[row0 + (i >> 2) * HALF + (i & 3) * 16];
#if Y_FP8
#pragma unroll
        for (int ai = 0; ai < 2; ++ai)
#pragma unroll
            for (int m = 0; m < 4; ++m) { const int row = row0 + ai * HALF + m * 16; const float s = sv[ai * 4 + m]; unsigned char* rowp = (unsigned char*)O + (size_t)row * D + col0;
                LAS unsigned char* xw = xl + (wr * 4 + wc) * 1280 + fr * 80;
#pragma unroll
                for (int bj = 0; bj < 2; ++bj) { const f32x4 v0 = acc[ai][bj][m][0] * s, v1 = acc[ai][bj][m][1] * s;
                    u32x2 w; w.x = pk4_fp8(v0[0], v0[1], v0[2], v0[3]); w.y = pk4_fp8(v1[0], v1[1], v1[2], v1[3]);
                    *(LAS u32x2*)(xw + 32 * bj + 8 * fq) = w; }
                const u32x4 row16 = *(const LAS u32x4*)(xw + 16 * fq);
                *(u32x4*)(rowp - 8 * fq + 16 * fq) = row16; }
#else
#pragma unroll
        for (int ai = 0; ai < 2; ++ai)
#pragma unroll
            for (int m = 0; m < 4; ++m) { const int row = row0 + ai * HALF + m * 16; const float s = sv[ai * 4 + m] * 0.0625f; bf16* rowp = O + (size_t)row * D + col0;
#pragma unroll
                for (int bj = 0; bj < 2; ++bj) { const f32x4 v0 = acc[ai][bj][m][0] * s, v1 = acc[ai][bj][m][1] * s;
                    u32x4 w; w.x = cvtpk(v0[0], v0[1]); w.y = cvtpk(v0[2], v0[3]); w.z = cvtpk(v1[0], v1[1]); w.w = cvtpk(v1[2], v1[3]);
                    *(u32x4*)(rowp + bj * 32) = w; } }
#endif
    }
};
}

struct Args { const float* in[25]; float* out; unsigned char* ws; int ph_lo, ph_hi; };
enum { I_X = 0, I_C, I_CTX, I_CCTX, I_ADAW, I_ADAB, I_NMIX, I_NFFN, I_HGWIN, I_HGLB, I_HGONG, I_HGWOUT, I_MWIN, I_MQNG, I_MKVNG, I_MWQB, I_MWKVB, I_MQQK, I_MKQK, I_MWOUT, I_GRP, I_EXP, I_WG, I_WU, I_WD };

typedef const __attribute__((address_space(4))) Args* KArgs;
struct Frame {
    LAS unsigned char* lds;
    int tid, lane, wave, G, gw, ngw;
    KArgs a;
    unsigned char* ws;
};

__device__ __forceinline__ void cvt_item(const float* W, int ldw, int k0, int n0, bf16* dst, int dst_ld, int dst_row0, const float* gain, int gmask, LAS float* scr, int lane, bool swaprow = false) {
    asm volatile("" : "+v"(lane));
    float tv[32];
#pragma unroll
    for (int i = 0; i < 32; ++i) tv[i] = W[(size_t)(k0 + 2 * i + (lane >> 5)) * ldw + n0 + (lane & 31)];
#pragma unroll
    for (int i = 0; i < 32; ++i) { const int kk = 2 * i + (lane >> 5); float v = tv[i]; if (gain) v *= gain[(k0 + kk) & gmask]; scr[kk * 33 + (lane & 31)] = v; }
    LDS_WAIT(); asm volatile("" ::: "memory");
    const int c = lane & 7;
#pragma unroll
    for (int j = 0; j < 4; ++j) { const int n = (lane >> 3) + 8 * j; const LAS float* s = scr + (8 * c) * 33 + n;
        u32x4 o; o.x = cvtpk(s[0 * 33], s[1 * 33]); o.y = cvtpk(s[2 * 33], s[3 * 33]); o.z = cvtpk(s[4 * 33], s[5 * 33]); o.w = cvtpk(s[6 * 33], s[7 * 33]);
        const int nd = swaprow ? ((n & ~12) | ((n & 4) << 1) | ((n & 8) >> 1)) : n;
        *(u32x4*)(dst + (size_t)(dst_row0 + nd) * dst_ld + k0 + 8 * c) = o; }
    LDS_WAIT(); asm volatile("" ::: "memory");
}
__device__ __forceinline__ void moe_convert(Frame& F, int layer, bf16* dst) {
    LAS float* scr = (LAS float*)(F.lds + F.wave * 16384);
    const float* wg = F.a->in[I_WG] + (size_t)layer * NEXP * D * FF; const float* wu = F.a->in[I_WU] + (size_t)layer * NEXP * D * FF; const float* wd = F.a->in[I_WD] + (size_t)layer * NEXP * FF * D;
    bf16* dgu = dst; bf16* dd = dst + (size_t)NEXP * 1024 * 1024;
    constexpr int IG = (D / 64) * (FF / 32);
    constexpr int IDN = (FF / 64) * (D / 32);
    constexpr int NIT = NEXP * (2 * IG + IDN);
    for (int it = F.gw; it < NIT; it += F.ngw) {
        const int e = it / (2 * IG + IDN); int r = it % (2 * IG + IDN);
        if (r < 2 * IG) { const int up = r >= IG; if (up) r -= IG; const int kb = r / (FF / 32), nb = r % (FF / 32); const int n0 = nb * 32;
            const int drow = (n0 >> 7) * 256 + up * 128 + (n0 & 127);
            cvt_item((up ? wu : wg) + (size_t)e * D * FF, FF, kb * 64, n0, dgu + (size_t)e * 1024 * 1024, 1024, drow, nullptr, 0, scr, F.lane); }
        else { r -= 2 * IG; const int kb = r / (D / 32), nb = r % (D / 32);
            cvt_item(wd + (size_t)e * FF * D, D, kb * 64, nb * 32, dd + (size_t)e * 1024 * 512, 512, nb * 32, nullptr, 0, scr, F.lane); }
    }
}

__device__ __forceinline__ void cvt_item8(const float* W, int ldw, int k0, int n0, unsigned char* dst, int dst_ld, int dst_row0, float sc, LAS float* scr, int lane, const float* gain = nullptr, int gmask = 0, bool swaprow = false) {
    asm volatile("" : "+v"(lane));
    float tv[32];
#pragma unroll
    for (int i = 0; i < 32; ++i) tv[i] = W[(size_t)(k0 + 2 * i + (lane >> 5)) * ldw + n0 + (lane & 31)];
#pragma unroll
    for (int i = 0; i < 32; ++i) { const int kk = 2 * i + (lane >> 5); float v = tv[i] * sc; if (gain) v *= gain[(k0 + kk) & gmask]; scr[kk * 33 + (lane & 31)] = v; }
    LDS_WAIT(); asm volatile("" ::: "memory");
    const int c = lane & 7;
#pragma unroll
    for (int j = 0; j < 4; ++j) { const int n = (lane >> 3) + 8 * j; const LAS float* p = scr + (8 * c) * 33 + n;
        u32x2 o; o.x = pk4_fp8(p[0 * 33], p[1 * 33], p[2 * 33], p[3 * 33]); o.y = pk4_fp8(p[4 * 33], p[5 * 33], p[6 * 33], p[7 * 33]);
        const int nd = swaprow ? ((n & ~12) | ((n & 4) << 1) | ((n & 8) >> 1)) : n;
        *(u32x2*)(dst + (size_t)(dst_row0 + nd) * dst_ld + k0 + 8 * c) = o; }
    LDS_WAIT(); asm volatile("" ::: "memory");
}
struct Cvt8Item { const float* W; unsigned char* dst; int ldw, k0, n0, dst_ld, drow; float sc; };
__device__ __forceinline__ Cvt8Item moe_item8(int it, const float* wg, const float* wu, const float* wd, unsigned char* dgu, unsigned char* dd) {
    constexpr int IG = (D / 64) * (FF / 32), IDN = (FF / 64) * (D / 32);
    const int e = it / (2 * IG + IDN); int r = it % (2 * IG + IDN); Cvt8Item c;
    if (r < 2 * IG) { const int up = r >= IG; if (up) r -= IG; const int kb = r / (FF / 32), nb = r % (FF / 32); const int n0 = nb * 32;
        c.W = (up ? wu : wg) + (size_t)e * D * FF; c.ldw = FF; c.k0 = kb * 64; c.n0 = n0; c.dst = dgu + (size_t)e * 1024 * 1024; c.dst_ld = 1024; c.drow = (n0 >> 7) * 256 + up * 128 + (n0 & 127); c.sc = 32.0f; }
    else { r -= 2 * IG; const int kb = r / (D / 32), nb = r % (D / 32);
        c.W = wd + (size_t)e * FF * D; c.ldw = D; c.k0 = kb * 64; c.n0 = nb * 32; c.dst = dd + (size_t)e * 1024 * 512; c.dst_ld = 512; c.drow = nb * 32; c.sc = 16.0f; }
    return c;
}
__device__ __forceinline__ void moe_convert8(Frame& F, int layer, unsigned char* dst, int it_lo = 0, int it_hi = 1 << 30, int wv = -1, int nwv = 0) {
    LAS float* scr = (LAS float*)(F.lds + F.wave * 16384);
    const float* wg = F.a->in[I_WG] + (size_t)layer * NEXP * D * FF; const float* wu = F.a->in[I_WU] + (size_t)layer * NEXP * D * FF; const float* wd = F.a->in[I_WD] + (size_t)layer * NEXP * FF * D;
    unsigned char* dgu = dst; unsigned char* dd = dst + (size_t)NEXP * 1024 * 1024;
    constexpr int IG = (D / 64) * (FF / 32), IDN = (FF / 64) * (D / 32), NIT = NEXP * (2 * IG + IDN);
    if (wv < 0) { wv = F.gw; nwv = F.ngw; }
    if (it_hi > NIT) it_hi = NIT;
    int it = it_lo + wv; if (it >= it_hi) return;
    int lane = F.lane; asm volatile("" : "+v"(lane));
    float tv[32];
    { const Cvt8Item c = moe_item8(it, wg, wu, wd, dgu, dd);
#pragma unroll
      for (int i = 0; i < 32; ++i) tv[i] = __builtin_nontemporal_load(c.W + (size_t)(c.k0 + 2 * i + (lane >> 5)) * c.ldw + c.n0 + (lane & 31)); }
    for (;;) {
        const Cvt8Item c = moe_item8(it, wg, wu, wd, dgu, dd);
        const int itn = it + nwv; const bool more = itn < it_hi;
        float tn[32];
        if (more) { const Cvt8Item cn = moe_item8(itn, wg, wu, wd, dgu, dd);
#pragma unroll
            for (int i = 0; i < 32; ++i) tn[i] = __builtin_nontemporal_load(cn.W + (size_t)(cn.k0 + 2 * i + (lane >> 5)) * cn.ldw + cn.n0 + (lane & 31)); }
#pragma unroll
        for (int i = 0; i < 32; ++i) scr[(2 * i + (lane >> 5)) * 33 + (lane & 31)] = tv[i] * c.sc;
        LDS_WAIT(); asm volatile("" ::: "memory");
        const int cc = lane & 7;
#pragma unroll
        for (int j = 0; j < 4; ++j) { const int n = (lane >> 3) + 8 * j; const LAS float* pp = scr + (8 * cc) * 33 + n;
            u32x2 o; o.x = pk4_fp8(pp[0 * 33], pp[1 * 33], pp[2 * 33], pp[3 * 33]); o.y = pk4_fp8(pp[4 * 33], pp[5 * 33], pp[6 * 33], pp[7 * 33]);
            *(u32x2*)(c.dst + (size_t)(c.drow + n) * c.dst_ld + c.k0 + 8 * cc) = o; }
        LDS_WAIT(); asm volatile("" ::: "memory");
        if (!more) break;
#pragma unroll
        for (int i = 0; i < 32; ++i) tv[i] = tn[i];
        it = itn;
    }
}

__device__ __forceinline__ float modulate_row(const f32x4 (&v)[4], const float* g, const float* modrow, int sh_chunk, bf16* orow, int lane, unsigned char* orow8 = nullptr) {
    float ss = 0.f;
#pragma unroll
    for (int j = 0; j < 4; ++j) ss += (v[j].x * v[j].x + v[j].y * v[j].y) + (v[j].z * v[j].z + v[j].w * v[j].w);
    const float r = 1.0f / sqrtf(wave_sum(ss) * (1.0f / D) + EPS);
#pragma unroll
    for (int j = 0; j < 4; ++j) { const int col = 4 * lane + 256 * j;
        const f32x4 gg = *(const f32x4*)(g + col), sh = *(const f32x4*)(modrow + sh_chunk * 1024 + col), sc = *(const f32x4*)(modrow + (sh_chunk + 1) * 1024 + col);
        const f32x4 y = (v[j] * r) * gg * (sc + 1.0f) + sh;
        if (orow) { u32x2 w; w.x = cvtpk(y.x, y.y); w.y = cvtpk(y.z, y.w); *(u32x2*)(orow + col) = w; }
        if (orow8) *(unsigned*)(orow8 + col) = pk4_fp8(y.x, y.y, y.z, y.w); }
    return r;
}
__device__ __forceinline__ int mod_row_of(int row) { return row < TC ? 32 : ((row - TC) >> 11); }

__device__ __forceinline__ void phase_prologue(Frame& F) {
    KArgs ap = F.a; unsigned char* ws = F.ws;
    LAS float* scr = (LAS float*)(F.lds + F.wave * 16384);
    {
        constexpr int I1 = 16 * 160, I2 = 16 * 32, I3 = 16 * 13, I4 = 4 * 48, I5 = 2 * 64, I6 = 16 * 32;
        constexpr int NIT = I1 + I2 + I3 + I4 + I5 + I6;
        for (int it = F.gw; it < NIT; it += F.ngw) {
            int r = it;
            if (r < I1) { cvt_item(ap->in[I_HGWIN], 5120, (r / 160) * 64, (r % 160) * 32, (bf16*)(ws + WS_W1T), 1024, (r % 160) * 32, nullptr, 0, scr, F.lane); continue; } r -= I1;
#if HG_FP8
            if (r < I2) { cvt_item8(ap->in[I_HGWOUT], 1024, (r / 32) * 64, (r % 32) * 32, ws + WS_W2T, 1024, (r % 32) * 32, 32.0f, scr, F.lane, ap->in[I_HGONG], 127); continue; } r -= I2;
#else
            if (r < I2) { cvt_item(ap->in[I_HGWOUT], 1024, (r / 32) * 64, (r % 32) * 32, (bf16*)(ws + WS_W2T), 1024, (r % 32) * 32, ap->in[I_HGONG], 127, scr, F.lane); continue; } r -= I2;
#endif
#if C_FP8
            if (r < I3) { cvt_item8(ap->in[I_MWIN], 416, (r / 13) * 64, (r % 13) * 32, ws + WS_WMIN, 1024, (r % 13) * 32, 32.0f, scr, F.lane); continue; } r -= I3;
#else
            if (r < I3) { cvt_item(ap->in[I_MWIN], 416, (r / 13) * 64, (r % 13) * 32, (bf16*)(ws + WS_WMIN), 1024, (r % 13) * 32, nullptr, 0, scr, F.lane); continue; } r -= I3;
#endif
#if Q_FP8
            if (r < I4) { cvt_item8(ap->in[I_MWQB], 1536, (r / 48) * 64, (r % 48) * 32, ws + WS_WQB, 256, (r % 48) * 32, 32.0f, scr, F.lane, ap->in[I_MQNG], 255, true); continue; } r -= I4;
#else
            if (r < I4) { cvt_item(ap->in[I_MWQB], 1536, (r / 48) * 64, (r % 48) * 32, (bf16*)(ws + WS_WQB), 256, (r % 48) * 32, ap->in[I_MQNG], 255, scr, F.lane, true); continue; } r -= I4;
#endif
            if (r < I5) { const int nb = r % 64, h = nb >> 2, part = nb & 3;
                const int drow = (part < 2) ? ((h >> 2) * 256 + part * 128 + (h & 3) * 32) : (1024 + h * 64 + (part - 2) * 32);
                cvt_item(ap->in[I_MWKVB], 2048, (r / 64) * 64, nb * 32, (bf16*)(ws + WS_WKVB), 128, drow, ap->in[I_MKVNG], 127, scr, F.lane); continue; } r -= I5;
#if AO_FP8
            cvt_item8(ap->in[I_MWOUT], 1024, (r / 32) * 64, (r % 32) * 32, ws + WS_W4T, 1024, (r % 32) * 32, 32.0f, scr, F.lane);
#else
            cvt_item(ap->in[I_MWOUT], 1024, (r / 32) * 64, (r % 32) * 32, (bf16*)(ws + WS_W4T), 1024, (r % 32) * 32, nullptr, 0, scr, F.lane);
#endif
        }
        const int gt = blockIdx.x * NTHR + F.tid, ngt = F.G * NTHR;
#if C_FP8
        for (int i = gt; i < 96 * 1024 / 4; i += ngt) ((unsigned*)(ws + WS_WMIN))[416 * 1024 / 4 + i] = 0u;
#else
        for (int i = gt; i < 96 * 1024 / 2; i += ngt) ((unsigned*)(ws + WS_WMIN))[416 * 1024 / 2 + i] = 0u;
#endif
        for (int i = gt; i < 2 * 64 * 1024; i += ngt) { const int l = i >> 16, n = (i >> 10) & 63, k = i & 1023; float v = 0.f;
            if (n < 32) v = ap->in[I_EXP][((size_t)l * 1024 + k) * 32 + n]; else if (n < 36) v = ap->in[I_GRP][((size_t)l * 1024 + k) * 4 + (n - 32)];
            ((bf16*)(ws + WS_WR))[i] = (bf16)(cvtpk(v, 0.f) & 0xffffu); }
        for (int i = gt; i < 2 * 1024; i += ngt) { const int dir = i >> 10, c = i & 1023; const float* p = ap->in[I_HGLB] + (size_t)dir * 3 * 1024 + c;
            const float v0 = p[0], v1 = p[1024], v2 = p[2048]; const float mx = fmaxf(v0, fmaxf(v1, v2)); const float e0 = expf(v0 - mx), e1 = expf(v1 - mx), e2 = expf(v2 - mx);
            ((float*)(ws + WS_LB))[i] = e0 / (e0 + e1 + e2); }
        for (int i = gt; i < 64 * 8; i += ngt) { const int p = i >> 3, k = i & 7; const float invf[8] = {1.0f, 0.31622776601683794f, 0.1f, 0.031622776601683794f, 0.01f, 0.0031622776601683794f, 0.001f, 0.00031622776601683794f};
            float fr = 1.0f;
#pragma unroll
            for (int q = 0; q < 8; ++q) if (q == k) fr = invf[q];
            const float ang = (float)p * fr; const float rev = ang * 0.15915494309189535f; const float fracr = rev - floorf(rev);
            ((float*)(ws + WS_ROPE))[i * 2 + 0] = __builtin_amdgcn_cosf(fracr); ((float*)(ws + WS_ROPE))[i * 2 + 1] = __builtin_amdgcn_sinf(fracr); }
    }
#if MOE_FP8
    moe_convert8(F, 0, ws + WS_MOEW0, 0, MOE0_SPLIT);
#else
    moe_convert(F, 0, (bf16*)(ws + WS_MOEW0));
#endif
    __syncthreads();
    if (blockIdx.x < 192) {
        const int layer = blockIdx.x / 96, col0 = (blockIdx.x % 96) * 64;
        const float* W = ap->in[I_ADAW] + (size_t)layer * D * 6144;
        int ln = F.lane; asm volatile("" : "+v"(ln));
        const int j32 = ln & 31, hh = ln >> 5, dw0 = F.wave * 128;
        LAS unsigned char* at = F.lds + F.wave * 17408;
        {
            f32x4 cv[17];
#pragma unroll
            for (int q = 0; q < 17; ++q) { const int i = ln + 64 * q, r = i >> 5, d4 = (i & 31) * 4; cv[q] = (f32x4){0.f, 0.f, 0.f, 0.f};
                if (i < 33 * 32) cv[q] = *(const f32x4*)((r < 32 ? ap->in[I_C] + r * 1024 : ap->in[I_CCTX]) + dw0 + d4); }
#pragma unroll
            for (int q = 0; q < 17; ++q) { const int i = ln + 64 * q, r = i >> 5, d4 = (i & 31) * 4;
                if (i < 33 * 32) { u32x2 w; w.x = cvtpk(silu_f(cv[q].x), silu_f(cv[q].y)); w.y = cvtpk(silu_f(cv[q].z), silu_f(cv[q].w)); *(LAS u32x2*)(at + r * 272 + d4 * 2) = w; } }
            for (int i = ln; i < 31 * 17; i += 64) { const int r = 33 + i / 17, c16 = i % 17; *(LAS u32x4*)(at + r * 272 + c16 * 16) = (u32x4){0u, 0u, 0u, 0u}; } }
        LDS_WAIT(); asm volatile("" ::: "memory");
        f32x16 acc[2][2];
#pragma unroll
        for (int rt = 0; rt < 2; ++rt)
#pragma unroll
            for (int nt = 0; nt < 2; ++nt) acc[rt][nt] = (f32x16){};
        const float* wl = W + (size_t)(dw0 + 8 * hh) * 6144 + col0 + j32;
#pragma unroll 2
        for (int ks = 0; ks < 8; ++ks) {
            float wv[2][8];
#pragma unroll
            for (int nt = 0; nt < 2; ++nt)
#pragma unroll
                for (int q = 0; q < 8; ++q) wv[nt][q] = __builtin_nontemporal_load(wl + (size_t)(16 * ks + q) * 6144 + 32 * nt);
            const bf16x8 a0 = *(const LAS bf16x8*)(at + j32 * 272 + (16 * ks + 8 * hh) * 2), a1 = *(const LAS bf16x8*)(at + (32 + j32) * 272 + (16 * ks + 8 * hh) * 2);
#pragma unroll
            for (int nt = 0; nt < 2; ++nt) { u32x4 w4; w4.x = cvtpk(wv[nt][0], wv[nt][1]); w4.y = cvtpk(wv[nt][2], wv[nt][3]); w4.z = cvtpk(wv[nt][4], wv[nt][5]); w4.w = cvtpk(wv[nt][6], wv[nt][7]);
                const bf16x8 bfr = __builtin_bit_cast(bf16x8, w4);
                acc[0][nt] = __builtin_amdgcn_mfma_f32_32x32x16_bf16(a0, bfr, acc[0][nt], 0, 0, 0); acc[1][nt] = __builtin_amdgcn_mfma_f32_32x32x16_bf16(a1, bfr, acc[1][nt], 0, 0, 0); }
        }
        __syncthreads();
        LAS float* part = (LAS float*)F.lds;
#pragma unroll
        for (int nt = 0; nt < 2; ++nt) {
#pragma unroll
            for (int r = 0; r < 16; ++r) part[(F.wave * 33 + (r & 3) + 8 * (r >> 2) + 4 * hh) * 64 + 32 * nt + j32] = acc[0][nt][r];
            if (hh == 0) part[(F.wave * 33 + 32) * 64 + 32 * nt + j32] = acc[1][nt][0]; }
        __syncthreads();
        for (int i = F.tid; i < 33 * 64; i += NTHR) { const int r = i >> 6, c = i & 63; float s = ap->in[I_ADAB][(size_t)layer * 6144 + col0 + c];
#pragma unroll
            for (int w = 0; w < 8; ++w) s += part[(w * 33 + r) * 64 + c];
            ((float*)(ws + WS_MOD))[((size_t)layer * 33 + r) * 6144 + col0 + c] = s; }
    }
}

__device__ __forceinline__ void phase_ew0_generic(Frame& F) {
    KArgs ap = F.a; const float* mod = (const float*)(F.ws + WS_MOD); bf16* H = (bf16*)(F.ws + WS_H);
    for (int row0 = 2 * F.gw; row0 < T; row0 += 2 * F.ngw) {
        f32x4 v[2][4];
#pragma unroll
        for (int rr = 0; rr < 2; ++rr) { const int row = row0 + rr; const float* xr = row < TC ? ap->in[I_CTX] + (size_t)row * D : ap->in[I_X] + (size_t)(row - TC) * D;
#pragma unroll
            for (int j = 0; j < 4; ++j) v[rr][j] = *(const f32x4*)(xr + 4 * F.lane + 256 * j); }
#pragma unroll
        for (int rr = 0; rr < 2; ++rr) { const int row = row0 + rr; modulate_row(v[rr], ap->in[I_NMIX], mod + (size_t)mod_row_of(row) * 6144, 0, H + (size_t)row * D, F.lane); }
    }
}

__device__ __forceinline__ void phase_ew0(Frame& F) {
    if (T % (16 * F.G)) { phase_ew0_generic(F); return; }
    KArgs ap = F.a; const float* mod = (const float*)(F.ws + WS_MOD); bf16* H = (bf16*)(F.ws + WS_H);
    const int rpw = T / F.G, ntrip = rpw / 16, base = (int)blockIdx.x * rpw + 2 * F.wave, lc = 4 * F.lane;
    f32x4 gv[4], shv[4], scv[4]; int cur_mr = -1;
#pragma unroll
    for (int j = 0; j < 4; ++j) gv[j] = *(const f32x4*)(ap->in[I_NMIX] + lc + 256 * j);
    f32x4 dv[2][4];
#pragma unroll
    for (int rr = 0; rr < 2; ++rr) { const int row = base + rr; const float* xr = (row < TC ? ap->in[I_CTX] + (size_t)row * D : ap->in[I_X] + (size_t)(row - TC) * D) + lc;
#pragma unroll
        for (int j = 0; j < 4; ++j) dv[rr][j] = __builtin_nontemporal_load((const f32x4*)(xr + 256 * j)); }
    for (int i = 0; i < ntrip; ++i) {
        const int row0 = base + 16 * i; const int mr = mod_row_of(row0);
        if (mr != cur_mr) { cur_mr = mr;
#pragma unroll
            for (int j = 0; j < 4; ++j) { shv[j] = *(const f32x4*)(mod + (size_t)mr * 6144 + lc + 256 * j); scv[j] = *(const f32x4*)(mod + (size_t)mr * 6144 + 1024 + lc + 256 * j); } }
        f32x4 nv[2][4];
        if (i + 1 < ntrip) {
#pragma unroll
            for (int rr = 0; rr < 2; ++rr) { const int row = row0 + 16 + rr; const float* xr = (row < TC ? ap->in[I_CTX] + (size_t)row * D : ap->in[I_X] + (size_t)(row - TC) * D) + lc;
#pragma unroll
                for (int j = 0; j < 4; ++j) nv[rr][j] = __builtin_nontemporal_load((const f32x4*)(xr + 256 * j)); } }
#pragma unroll
        for (int rr = 0; rr < 2; ++rr) { const int row = row0 + rr; float ss = 0.f;
#pragma unroll
            for (int j = 0; j < 4; ++j) ss += (dv[rr][j].x * dv[rr][j].x + dv[rr][j].y * dv[rr][j].y) + (dv[rr][j].z * dv[rr][j].z + dv[rr][j].w * dv[rr][j].w);
            const float r = 1.0f / sqrtf(wave_sum(ss) * (1.0f / D) + EPS);
#pragma unroll
            for (int j = 0; j < 4; ++j) { const f32x4 y = (dv[rr][j] * r) * gv[j] * (scv[j] + 1.0f) + shv[j]; u32x2 w; w.x = cvtpk(y.x, y.y); w.y = cvtpk(y.z, y.w); *(u32x2*)(H + (size_t)row * D + lc + 256 * j) = w; } }
#pragma unroll
        for (int rr = 0; rr < 2; ++rr)
#pragma unroll
            for (int j = 0; j < 4; ++j) dv[rr][j] = nv[rr][j];
    }
}

constexpr int GL_IMG = 8704, QGP = 320, GL_G = 32 * QGP, GL_V = 2 * 32 * QGP, GL_QD = GL_V + 2 * GL_IMG, GL_KD = GL_QD + 8192, GL_EB = GL_KD + 8192, GL_O = GL_EB + 512, GL_CHAIN = GL_O + 8704;
__device__ __forceinline__ unsigned offq(unsigned row, unsigned ch) { return (unsigned)QGP * row + 16u * ch; }
__device__ __forceinline__ unsigned offt(unsigned c, unsigned q) { return 64u * c + 8u * (q ^ ((c >> 2) & 7u)); }
__device__ __forceinline__ unsigned offb(unsigned row, unsigned ch) { return 272u * row + 16u * ch; }
__device__ __forceinline__ float scan32(float v) {
#define DPP_ADD(ctrl, rmask) v += __builtin_bit_cast(float, __builtin_amdgcn_update_dpp(0, __builtin_bit_cast(int, v), ctrl, rmask, 0xf, false))
    DPP_ADD(0x111, 0xf); DPP_ADD(0x112, 0xf); DPP_ADD(0x114, 0xf); DPP_ADD(0x118, 0xf); DPP_ADD(0x142, 0xa);
#undef DPP_ADD
    return v;
}
__device__ __forceinline__ float scanmul32(float v) {
#define DPP_MUL(ctrl, rmask) v *= __builtin_bit_cast(float, __builtin_amdgcn_update_dpp(0x3f800000, __builtin_bit_cast(int, v), ctrl, rmask, 0xf, false))
    DPP_MUL(0x111, 0xf); DPP_MUL(0x112, 0xf); DPP_MUL(0x114, 0xf); DPP_MUL(0x118, 0xf); DPP_MUL(0x142, 0xa);
#undef DPP_MUL
    return v;
}
typedef short v4i16_t __attribute__((ext_vector_type(4)));
__device__ __forceinline__ u32x2 tr_read4(const LAS unsigned char* p) { return __builtin_bit_cast(u32x2, __builtin_amdgcn_ds_read_tr16_b64_v4i16((LAS v4i16_t*)p)); }
__device__ __forceinline__ int gla_row(int dir, int b, int i) {
    if (dir == 0) return (i < CTXL) ? b * CTXL + i : TC + b * SEQ + (i - CTXL);
    return (i < CTXL) ? b * CTXL + (CTXL - 1 - i) : TC + b * SEQ + (SEQ - 1 - (i - CTXL));
}
constexpr size_t A8_OFF = (size_t)160 << 20;
struct GlaOut { u32x4 oth[2], g4[2]; };
__device__ __forceinline__ void gla_fetch(GlaOut& go, const LAS unsigned char* cb, int dir, int b, int hd, int jc, int sp_r0, int sp_ch, int sgn, const bf16* P, const bf16* Other) {
    const int rel = jc < 8 ? jc : jc - 8; const bool fuse = jc < 8 ? (rel >= 4) : (rel >= 32);
    const int row0 = gla_row(dir, b, 32 * jc + sp_r0);
#pragma unroll
    for (int i = 0; i < 2; ++i) { const int row = row0 + sgn * 16 * i; const size_t off = (size_t)row * D + hd * 128 + sp_ch * 8;
        if (fuse) { go.oth[i] = *(const u32x4*)(Other + off); go.g4[i] = __builtin_nontemporal_load((const u32x4*)(P + (size_t)row * 5120 + 4096 + hd * 128 + sp_ch * 8)); } }
}
__device__ __forceinline__ void gla_finish(const GlaOut& go, const LAS unsigned char* cb, int dir, int b, int hd, int jc, int sp_r0, int sp_ch, int sgn, bf16* Mine, bf16* Aout) {
    const int rel = jc < 8 ? jc : jc - 8; const bool fuse = jc < 8 ? (rel >= 4) : (rel >= 32);
    const int row0 = gla_row(dir, b, 32 * jc + sp_r0);
#pragma unroll
    for (int i = 0; i < 2; ++i) { const int row = row0 + sgn * 16 * i; const size_t off = (size_t)row * D + hd * 128 + sp_ch * 8;
        const u32x4 mine = *(const LAS u32x4*)(cb + GL_O + (sp_r0 + 16 * i) * 272 + sp_ch * 16);
        if (!fuse) { *(u32x4*)(Mine + off) = mine; }
        else { const u32x4 oth = go.oth[i]; const u32x4 g4 = go.g4[i];
            float o[8]; float ss = 0.f;
#pragma unroll
            for (int q = 0; q < 4; ++q) { o[2 * q] = bflo(mine[q]) + bflo(oth[q]); o[2 * q + 1] = bfhi(mine[q]) + bfhi(oth[q]); ss += o[2 * q] * o[2 * q] + o[2 * q + 1] * o[2 * q + 1]; }
            ss += __shfl_xor(ss, 1); ss += __shfl_xor(ss, 2); ss += __shfl_xor(ss, 4); ss += __shfl_xor(ss, 8);
            const float r = 1.0f / sqrtf(ss * (1.0f / HGD) + EPS);
#if HG_FP8
            const float r8 = 8.0f * r;
#pragma unroll
            for (int q = 0; q < 4; ++q) { o[2 * q] = o[2 * q] * r8 * silu_f(bflo(g4[q])); o[2 * q + 1] = o[2 * q + 1] * r8 * silu_f(bfhi(g4[q])); }
            u32x2 w8; w8.x = pk4_fp8(o[0], o[1], o[2], o[3]); w8.y = pk4_fp8(o[4], o[5], o[6], o[7]);
            *(u32x2*)((unsigned char*)Aout + A8_OFF + (size_t)row * D + hd * 128 + sp_ch * 8) = w8; } }
#else
            u32x4 w;
#pragma unroll
            for (int q = 0; q < 4; ++q) w[q] = cvtpk(o[2 * q] * r * silu_f(bflo(g4[q])), o[2 * q + 1] * r * silu_f(bfhi(g4[q])));
            *(u32x4*)(Aout + off) = w; } }
#endif
}
__device__ __forceinline__ void gla_store(const LAS unsigned char* cb, int dir, int b, int hd, int jc, int sp_r0, int sp_ch, int sgn, const bf16* P, bf16* Mine, const bf16* Other, bf16* Aout) {
    GlaOut go; gla_fetch(go, cb, dir, b, hd, jc, sp_r0, sp_ch, sgn, P, Other); gla_finish(go, cb, dir, b, hd, jc, sp_r0, sp_ch, sgn, Mine, Aout);
}
__device__ __forceinline__ void phase_gla(Frame& F) {
    const bf16* P = (const bf16*)(F.ws + WS_P);
    bf16* OF = (bf16*)F.a->out; bf16* OB = (bf16*)(F.ws + WS_H);
    const int dir = F.tid >> 8, ht = F.tid & 255, lane = F.lane, hi = lane >> 5, wq = F.wave & 3; const unsigned t32_0 = lane & 31;
    LAS unsigned char* cb = F.lds + dir * GL_CHAIN;
    const int sp_ch = ht & 15, sp_r0 = ht >> 4;
    const unsigned trh = lane >> 5, trblk = (lane >> 4) & 1, trq0 = (lane & 15) >> 2, trp = lane & 3;
    const int sgn = dir ? -1 : 1;
    for (int chain = blockIdx.x; chain < NB * HGH; chain += F.G) {
        const int b = chain >> 3, hd = chain & 7;
        bf16* Out = dir ? OB : OF;
        f32x16 S[4];
#pragma unroll
        for (int c = 0; c < 4; ++c) S[c] = (f32x16){};
        u32x4 rq[2], rg[2], rv[2];
        {   const bf16* pr0 = P + (size_t)gla_row(dir, b, sp_r0) * 5120 + hd * 128 + sp_ch * 8;
#pragma unroll
            for (int i = 0; i < 2; ++i) { const bf16* pr = pr0 + (ptrdiff_t)sgn * 16 * i * 5120; rq[i] = __builtin_nontemporal_load((const u32x4*)pr); rg[i] = __builtin_nontemporal_load((const u32x4*)(pr + 1024 * (1 + dir))); rv[i] = __builtin_nontemporal_load((const u32x4*)(pr + 3072)); } }
#pragma unroll
        for (int i = 0; i < 2; ++i) { const unsigned o = offq(sp_r0 + 16 * i, sp_ch); *(LAS u32x4*)(cb + o) = rq[i]; *(LAS u32x4*)(cb + GL_G + o) = rg[i]; *(LAS u32x4*)(cb + GL_V + offb(sp_r0 + 16 * i, sp_ch)) = rv[i]; }
        __syncthreads();
        constexpr int NCH = KVLEN / 32;
        for (int j = 0; j < NCH; ++j) {
            const unsigned trq = trq0, t32 = t32_0;
            if (j + 1 < NCH) { const bf16* pr0 = P + (size_t)gla_row(dir, b, 32 * (j + 1) + sp_r0) * 5120 + hd * 128 + sp_ch * 8;
#pragma unroll
                for (int i = 0; i < 2; ++i) { const bf16* pr = pr0 + (ptrdiff_t)sgn * 16 * i * 5120; rq[i] = __builtin_nontemporal_load((const u32x4*)pr); rg[i] = __builtin_nontemporal_load((const u32x4*)(pr + 1024 * (1 + dir))); } }
            GlaOut go; if (j > 0) gla_fetch(go, cb, dir, b, hd, j - 1, sp_r0, sp_ch, sgn, P, dir ? OF : OB);
            {   unsigned ln = (unsigned)lane; asm volatile("" : "+v"(ln));
                const unsigned i16 = ln & 15u, cblk = (ln >> 4) & 1u, th = ln >> 5, c = 32u * wq + (ln & 31u);
                const unsigned bin = (unsigned)QGP * (16u * th + (i16 >> 2)) + 64u * wq + 32u * cblk + 8u * (i16 & 3u);
                float g[16], q[16], e[16];
#pragma unroll
                for (int r = 0; r < 4; ++r) { const u32x2 g2 = tr_read4(cb + GL_G + bin + QGP * 4 * r), q2 = tr_read4(cb + bin + QGP * 4 * r);
                    g[4 * r] = bflo(g2.x); g[4 * r + 1] = bfhi(g2.x); g[4 * r + 2] = bflo(g2.y); g[4 * r + 3] = bfhi(g2.y); q[4 * r] = bflo(q2.x); q[4 * r + 1] = bfhi(q2.x); q[4 * r + 2] = bflo(q2.y); q[4 * r + 3] = bfhi(q2.y); }
                e[0] = g[0];
#pragma unroll
                for (int i = 1; i < 16; ++i) e[i] = e[i - 1] * g[i];
                const float tot = __shfl_xor(e[15], 32); const float mh = th ? tot : 1.0f;
#pragma unroll
                for (int i = 0; i < 16; ++i) e[i] *= mh;
#pragma unroll
                for (int r = 0; r < 4; ++r) { float qd[4], kd[4];
#pragma unroll
                    for (int i = 0; i < 4; ++i) { const float ei = fast_rcp(e[4 * r + i]); const float kk = 1.0f - g[4 * r + i]; qd[i] = q[4 * r + i] * e[4 * r + i]; kd[i] = kk * ei; }
                    u32x2 wqd, wkd; wqd.x = cvtpk(qd[0], qd[1]); wqd.y = cvtpk(qd[2], qd[3]); wkd.x = cvtpk(kd[0], kd[1]); wkd.y = cvtpk(kd[2], kd[3]);
                    const unsigned o = offt(c, 4u * th + r); *(LAS u32x2*)(cb + GL_QD + o) = wqd; *(LAS u32x2*)(cb + GL_KD + o) = wkd; }
                if (th) *(LAS float*)(cb + GL_EB + c * 4u) = e[15]; }
            if (j > 0) gla_finish(go, cb, dir, b, hd, j - 1, sp_r0, sp_ch, sgn, Out, OF);
            __syncthreads();
            if (j + 1 < NCH) {
                const bf16* pv0 = P + (size_t)gla_row(dir, b, 32 * (j + 1) + sp_r0) * 5120 + hd * 128 + sp_ch * 8 + 3072;
#pragma unroll
                for (int i = 0; i < 2; ++i) rv[i] = __builtin_nontemporal_load((const u32x4*)(pv0 + (ptrdiff_t)sgn * 16 * i * 5120));
            }
            bf16x8 qd[8];
            f32x16 X = (f32x16){};
            unsigned xb[4];
            { const unsigned i16 = t32 & 15u, blk = t32 >> 4, qh = (4u * blk + (i16 & 3u)) ^ (unsigned)hi;
#pragma unroll
              for (int K = 0; K < 4; ++K) xb[K] = ((i16 >> 2) + 4u * hi) * 64u + ((qh ^ (2u * K)) * 8u); }
#pragma unroll
            for (int ks = 0; ks < 8; ++ks) { const unsigned o0 = xb[2 * (ks & 1)] + (16 * ks) * 64, o1 = xb[2 * (ks & 1) + 1] + (16 * ks + 8) * 64;
                const u32x2 a0 = tr_read4(cb + GL_QD + o0), a1 = tr_read4(cb + GL_QD + o1), k0 = tr_read4(cb + GL_KD + o0), k1 = tr_read4(cb + GL_KD + o1);
                qd[ks] = __builtin_bit_cast(bf16x8, (u32x4){a0.x, a0.y, a1.x, a1.y}); const bf16x8 kdf = __builtin_bit_cast(bf16x8, (u32x4){k0.x, k0.y, k1.x, k1.y});
                X = __builtin_amdgcn_mfma_f32_32x32x16_bf16(kdf, qd[ks], X, 0, 0, 0);
                if ((ks & 3) == 3) __builtin_amdgcn_sched_barrier(0); }
#pragma unroll
            for (int r = 0; r < 16; ++r) { const int sr = (r & 3) + 8 * (r >> 2) + 4 * hi; X[r] = (sr <= (int)t32) ? X[r] : 0.f; }
            bf16x8 xa[2];
            { u32x4 w; w.x = cvtpk(X[0], X[1]); w.y = cvtpk(X[2], X[3]); w.z = cvtpk(X[4], X[5]); w.w = cvtpk(X[6], X[7]); xa[0] = __builtin_bit_cast(bf16x8, w);
              w.x = cvtpk(X[8], X[9]); w.y = cvtpk(X[10], X[11]); w.z = cvtpk(X[12], X[13]); w.w = cvtpk(X[14], X[15]); xa[1] = __builtin_bit_cast(bf16x8, w); }
            const LAS unsigned char* vbase = cb + GL_V + (j & 1) * GL_IMG;
            bf16x8 vb[2];
#pragma unroll
            for (int kk = 0; kk < 2; ++kk) { const u32x2 p0 = tr_read4(vbase + offb(16 * kk + 0 + 4 * trh + trq, 4 * wq + 2 * trblk + (trp >> 1)) + 8 * (trp & 1)), p1 = tr_read4(vbase + offb(16 * kk + 8 + 4 * trh + trq, 4 * wq + 2 * trblk + (trp >> 1)) + 8 * (trp & 1));
                vb[kk] = __builtin_bit_cast(bf16x8, (u32x4){p0.x, p0.y, p1.x, p1.y}); }
            f32x16 O = (f32x16){}, O2 = (f32x16){};
            O = __builtin_amdgcn_mfma_f32_32x32x16_bf16(vb[0], xa[0], O, 0, 0, 0); O = __builtin_amdgcn_mfma_f32_32x32x16_bf16(vb[1], xa[1], O, 0, 0, 0);
#pragma unroll
            for (int ct = 0; ct < 4; ++ct)
#pragma unroll
                for (int kk = 0; kk < 2; ++kk) { u32x4 w; w.x = cvtpk(S[ct][8 * kk], S[ct][8 * kk + 1]); w.y = cvtpk(S[ct][8 * kk + 2], S[ct][8 * kk + 3]); w.z = cvtpk(S[ct][8 * kk + 4], S[ct][8 * kk + 5]); w.w = cvtpk(S[ct][8 * kk + 6], S[ct][8 * kk + 7]);
                    O2 = __builtin_amdgcn_mfma_f32_32x32x16_bf16(__builtin_bit_cast(bf16x8, w), qd[2 * ct + kk], O2, 0, 0, 0); }
#pragma unroll
            for (int r = 0; r < 16; ++r) O[r] += O2[r];
            unsigned sb[4];
            { const unsigned fh = ((t32 >> 2) & 7u) ^ (unsigned)hi;
#pragma unroll
              for (int K = 0; K < 4; ++K) sb[K] = t32 * 64u + ((fh ^ (2u * K)) * 8u); }
#pragma unroll
            for (int ct = 0; ct < 4; ++ct) {
#pragma unroll
                for (int kk = 0; kk < 2; ++kk) { const u32x2 p0 = *(const LAS u32x2*)(cb + GL_KD + sb[2 * kk] + 32 * ct * 64), p1 = *(const LAS u32x2*)(cb + GL_KD + sb[2 * kk + 1] + 32 * ct * 64);
                    S[ct] = __builtin_amdgcn_mfma_f32_32x32x16_bf16(__builtin_bit_cast(bf16x8, (u32x4){p0.x, p0.y, p1.x, p1.y}), vb[kk], S[ct], 0, 0, 0); }
#pragma unroll
                for (int g = 0; g < 4; ++g) { const f32x4 eb = *(const LAS f32x4*)(cb + GL_EB + (32 * ct + 8 * g + 4 * hi) * 4);
                    S[ct][4 * g] *= eb.x; S[ct][4 * g + 1] *= eb.y; S[ct][4 * g + 2] *= eb.z; S[ct][4 * g + 3] *= eb.w; }
            }
#pragma unroll
            for (int g = 0; g < 4; ++g) { u32x2 w; w.x = cvtpk(O[4 * g], O[4 * g + 1]); w.y = cvtpk(O[4 * g + 2], O[4 * g + 3]);
                *(LAS u32x2*)(cb + GL_O + t32 * 272 + (32 * wq + 8 * g + 4 * hi) * 2) = w; }
            if (j + 1 < NCH) {
#pragma unroll
                for (int i = 0; i < 2; ++i) { *(LAS u32x4*)(cb + GL_V + ((j + 1) & 1) * GL_IMG + offb(sp_r0 + 16 * i, sp_ch)) = rv[i];
                    const unsigned o = offq(sp_r0 + 16 * i, sp_ch); *(LAS u32x4*)(cb + o) = rq[i]; *(LAS u32x4*)(cb + GL_G + o) = rg[i]; }
            }
            asm volatile("s_waitcnt vmcnt(0)" ::: "memory");
            __syncthreads();
        }
        gla_store(cb, dir, b, hd, NCH - 1, sp_r0, sp_ch, sgn, P, Out, dir ? OF : OB, OF);
        __syncthreads();
    }
}

__device__ __forceinline__ void phase_ew1(Frame& F) {
    const bf16* P = (const bf16*)(F.ws + WS_P); bf16* OF = (bf16*)F.a->out; const bf16* OB = (const bf16*)(F.ws + WS_H);
    for (int row = F.gw; row < T; row += F.ngw) {
#pragma unroll
        for (int j = 0; j < 4; ++j) { const int col = 4 * F.lane + 256 * j;
            const u32x2 a2 = *(const u32x2*)(OF + (size_t)row * D + col), b2 = *(const u32x2*)(OB + (size_t)row * D + col), g2 = *(const u32x2*)(P + (size_t)row * 5120 + 4096 + col);
            float o[4] = {bflo(a2.x) + bflo(b2.x), bfhi(a2.x) + bfhi(b2.x), bflo(a2.y) + bflo(b2.y), bfhi(a2.y) + bfhi(b2.y)};
            float ss = (o[0] * o[0] + o[1] * o[1]) + (o[2] * o[2] + o[3] * o[3]);
            ss = half_sum(ss);
            const float r = 1.0f / sqrtf(ss * (1.0f / HGD) + EPS);
            u32x2 w; w.x = cvtpk(o[0] * r * bflo(g2.x), o[1] * r * bfhi(g2.x)); w.y = cvtpk(o[2] * r * bflo(g2.y), o[3] * r * bfhi(g2.y));
            *(u32x2*)(OF + (size_t)row * D + col) = w; }
    }
}

__device__ __forceinline__ void phase_ew2_generic(Frame& F, int layer, const bf16* X, int row_lo, int xrow_off, unsigned char* H8) {
    KArgs ap = F.a; const float* mod = (const float*)(F.ws + WS_MOD) + (size_t)layer * 33 * 6144; bf16* H = (bf16*)(F.ws + WS_H);
    for (int row0 = row_lo + 2 * F.gw; row0 < T; row0 += 2 * F.ngw) {
        u32x2 xw[2][4];
#pragma unroll
        for (int rr = 0; rr < 2; ++rr) { const bf16* xr = X + (size_t)(row0 + rr - xrow_off) * D;
#pragma unroll
            for (int j = 0; j < 4; ++j) xw[rr][j] = *(const u32x2*)(xr + 4 * F.lane + 256 * j); }
#pragma unroll
        for (int rr = 0; rr < 2; ++rr) { const int row = row0 + rr; f32x4 v[4];
#pragma unroll
            for (int j = 0; j < 4; ++j) v[j] = (f32x4){bflo(xw[rr][j].x), bfhi(xw[rr][j].x), bflo(xw[rr][j].y), bfhi(xw[rr][j].y)};
            const float r = modulate_row(v, ap->in[I_NFFN] + (size_t)layer * D, mod + (size_t)mod_row_of(row) * 6144, 3, H8 ? nullptr : H + (size_t)row * D, F.lane, H8 ? H8 + (size_t)row * D : nullptr);
            if (F.lane == 0) ((float*)(F.ws + WS_RMS))[row] = r; }
    }
}

__device__ __forceinline__ void phase_ew2(Frame& F, int layer, const bf16* X, int row_lo, int xrow_off, unsigned char* H8) {
    if (!H8 || ((T - row_lo) % (16 * F.G))) { phase_ew2_generic(F, layer, X, row_lo, xrow_off, H8); return; }
    KArgs ap = F.a; const float* mod = (const float*)(F.ws + WS_MOD) + (size_t)layer * 33 * 6144; float* rms = (float*)(F.ws + WS_RMS);
    const int rpw = (T - row_lo) / F.G, ntrip = rpw / 16, base = row_lo + (int)blockIdx.x * rpw + 2 * F.wave, lc = 4 * F.lane;
    f32x4 gv[4], shv[4], scv[4]; int cur_mr = -1;
#pragma unroll
    for (int j = 0; j < 4; ++j) gv[j] = *(const f32x4*)(ap->in[I_NFFN] + (size_t)layer * D + lc + 256 * j);
    u32x2 dv[2][4];
#pragma unroll
    for (int rr = 0; rr < 2; ++rr) { const bf16* xr = X + (size_t)(base + rr - xrow_off) * D + lc;
#pragma unroll
        for (int j = 0; j < 4; ++j) dv[rr][j] = *(const u32x2*)(xr + 256 * j); }
    for (int i = 0; i < ntrip; ++i) {
        const int row0 = base + 16 * i; const int mr = mod_row_of(row0);
        if (mr != cur_mr) { cur_mr = mr;
#pragma unroll
            for (int j = 0; j < 4; ++j) { shv[j] = *(const f32x4*)(mod + (size_t)mr * 6144 + 3 * 1024 + lc + 256 * j); scv[j] = *(const f32x4*)(mod + (size_t)mr * 6144 + 4 * 1024 + lc + 256 * j); } }
        u32x2 nv[2][4];
        if (i + 1 < ntrip) {
#pragma unroll
            for (int rr = 0; rr < 2; ++rr) { const bf16* xr = X + (size_t)(row0 + 16 + rr - xrow_off) * D + lc;
#pragma unroll
                for (int j = 0; j < 4; ++j) nv[rr][j] = *(const u32x2*)(xr + 256 * j); } }
#pragma unroll
        for (int rr = 0; rr < 2; ++rr) { const int row = row0 + rr; f32x4 v[4]; float ss = 0.f;
#pragma unroll
            for (int j = 0; j < 4; ++j) { v[j] = (f32x4){bflo(dv[rr][j].x), bfhi(dv[rr][j].x), bflo(dv[rr][j].y), bfhi(dv[rr][j].y)}; ss += (v[j].x * v[j].x + v[j].y * v[j].y) + (v[j].z * v[j].z + v[j].w * v[j].w); }
            const float r = 1.0f / sqrtf(wave_sum(ss) * (1.0f / D) + EPS);
#pragma unroll
            for (int j = 0; j < 4; ++j) { const f32x4 y = (v[j] * r) * gv[j] * (scv[j] + 1.0f) + shv[j]; *(unsigned*)(H8 + (size_t)row * D + lc + 256 * j) = pk4_fp8(y.x, y.y, y.z, y.w); }
            if (F.lane == 0) rms[row] = r; }
#pragma unroll
        for (int rr = 0; rr < 2; ++rr)
#pragma unroll
            for (int j = 0; j < 4; ++j) dv[rr][j] = nv[rr][j];
    }
}

__device__ __forceinline__ void phase_router_tables(Frame& F) {
    KArgs ap = F.a; const float* mod = (const float*)(F.ws + WS_MOD); const bf16* WrT = (const bf16*)(F.ws + WS_WR); bf16* WP = (bf16*)(F.ws + WS_WRP); float* CB = (float*)(F.ws + WS_CB);
    const int gt = blockIdx.x * NTHR + F.tid, ngt = F.G * NTHR;
    for (int i0 = gt; i0 < 2 * 33 * 64 * 256; i0 += 4 * ngt) {
        u32x2 w2[4]; f32x4 g4[4], sc[4];
#pragma unroll
        for (int q = 0; q < 4; ++q) { const int i4 = i0 + q * ngt; if (i4 < 2 * 33 * 64 * 256) { const int k = (i4 & 255) * 4, n = (i4 >> 8) & 63, lb = i4 >> 14, l = lb / 33;
            w2[q] = *(const u32x2*)(WrT + ((size_t)l * 64 + n) * 1024 + k); g4[q] = *(const f32x4*)(ap->in[I_NFFN] + (size_t)l * D + k); sc[q] = *(const f32x4*)(mod + (size_t)lb * 6144 + 4 * 1024 + k); } }
#pragma unroll
        for (int q = 0; q < 4; ++q) { const int i4 = i0 + q * ngt; if (i4 < 2 * 33 * 64 * 256) { const int k = (i4 & 255) * 4, n = (i4 >> 8) & 63, lb = i4 >> 14;
            u32x2 o; o.x = cvtpk(bflo(w2[q].x) * g4[q].x * (sc[q].x + 1.0f), bfhi(w2[q].x) * g4[q].y * (sc[q].y + 1.0f)); o.y = cvtpk(bflo(w2[q].y) * g4[q].z * (sc[q].z + 1.0f), bfhi(w2[q].y) * g4[q].w * (sc[q].w + 1.0f));
            *(u32x2*)(WP + ((size_t)lb * 64 + n) * 1024 + k) = o; } } }
    for (int task = F.gw; task < 2 * 33 * 64; task += F.ngw) { const int n = task & 63, lb = task >> 6, l = lb / 33; float sacc = 0.f;
        if (n < 36) {
#pragma unroll
            for (int j = 0; j < 4; ++j) { const int k = 4 * F.lane + 256 * j; const u32x2 w2 = *(const u32x2*)(WrT + ((size_t)l * 64 + n) * 1024 + k); const f32x4 sh = *(const f32x4*)(mod + (size_t)lb * 6144 + 3 * 1024 + k);
                sacc += (bflo(w2.x) * sh.x + bfhi(w2.x) * sh.y) + (bflo(w2.y) * sh.z + bfhi(w2.y) * sh.w); }
            sacc = wave_sum(sacc); }
        if (F.lane == 0) CB[task] = sacc; }
}

__device__ __forceinline__ void phase_router(Frame& F, int layer, int tok0, int tpw, const bf16* X, int xrow_off) {
    const bf16* WP = (const bf16*)(F.ws + WS_WRP) + (size_t)layer * 33 * 64 * 1024; const float* CB = (const float*)(F.ws + WS_CB) + layer * 33 * 64; const float* rms = (const float*)(F.ws + WS_RMS);
    int* eid = (int*)(F.ws + WS_EID); float* gwt = (float*)(F.ws + WS_GW); int* cnt = (int*)(F.ws + WS_CNT);
    constexpr int WPITCH = 2064;
    LAS int* lcnt = (LAS int*)(F.lds + 64 * WPITCH);
    if (F.tid < 32) lcnt[F.tid] = 0;
    const int mb0 = mod_row_of(tok0 + (int)blockIdx.x * tpw);
    for (int i = F.tid; i < 64 * 128; i += NTHR) { const int row = i >> 7, ch = i & 127; *(LAS u32x4*)(F.lds + row * WPITCH + ch * 16) = *(const u32x4*)(WP + ((size_t)mb0 * 64 + row) * 1024 + ch * 8); }
    __syncthreads();
    const int ntask = tpw / 32; const int r32 = F.lane & 31, hh = F.lane >> 5;
    for (int task = F.wave; task < ntask; task += NWAVES) {
        const int tokb = tok0 + blockIdx.x * tpw + task * 32, tok = tokb + r32, mb = mod_row_of(tokb);
        const bf16* WrT = WP + (size_t)mb * 64 * 1024; const float* cb = CB + mb * 64;
        const bf16* hrow = X + (size_t)(tok - xrow_off) * D + 8 * hh; const bf16* w0 = WrT + (size_t)r32 * D + 8 * hh; const bf16* w1 = WrT + (size_t)(32 + r32) * D + 8 * hh;
        f32x16 acc0 = {}, acc1 = {};
        if (mb == mb0) {
            const LAS unsigned char* l0 = F.lds + r32 * WPITCH + 16 * hh; const LAS unsigned char* l1 = l0 + 32 * WPITCH;
#pragma unroll 8
            for (int ks = 0; ks < 64; ++ks) { const bf16x8 bfr = *(const bf16x8*)(hrow + 16 * ks), a0 = *(const LAS bf16x8*)(l0 + 32 * ks), a1 = *(const LAS bf16x8*)(l1 + 32 * ks);
                acc0 = __builtin_amdgcn_mfma_f32_32x32x16_bf16(a0, bfr, acc0, 0, 0, 0); acc1 = __builtin_amdgcn_mfma_f32_32x32x16_bf16(a1, bfr, acc1, 0, 0, 0); }
        } else {
#pragma unroll 4
            for (int ks = 0; ks < 64; ++ks) { const bf16x8 bfr = *(const bf16x8*)(hrow + 16 * ks), a0 = *(const bf16x8*)(w0 + 16 * ks), a1 = *(const bf16x8*)(w1 + 16 * ks);
                acc0 = __builtin_amdgcn_mfma_f32_32x32x16_bf16(a0, bfr, acc0, 0, 0, 0); acc1 = __builtin_amdgcn_mfma_f32_32x32x16_bf16(a1, bfr, acc1, 0, 0, 0); }
        }
        { const float rt = __builtin_bit_cast(float, __hip_atomic_load((const unsigned*)(rms + tok), __ATOMIC_RELAXED, __HIP_MEMORY_SCOPE_AGENT));
#pragma unroll
          for (int g = 0; g < 4; ++g) { const f32x4 c4 = *(const f32x4*)(cb + 8 * g + 4 * hh); acc0[4 * g] = acc0[4 * g] * rt + c4.x; acc0[4 * g + 1] = acc0[4 * g + 1] * rt + c4.y; acc0[4 * g + 2] = acc0[4 * g + 2] * rt + c4.z; acc0[4 * g + 3] = acc0[4 * g + 3] * rt + c4.w; }
          const f32x4 c4 = *(const f32x4*)(cb + 32 + 4 * hh); acc1[0] = acc1[0] * rt + c4.x; acc1[1] = acc1[1] * rt + c4.y; acc1[2] = acc1[2] * rt + c4.z; acc1[3] = acc1[3] * rt + c4.w; }
        int gs = 0; float gm = acc1[0];
        if (acc1[1] > gm) { gm = acc1[1]; gs = 1; } if (acc1[2] > gm) { gm = acc1[2]; gs = 2; } if (acc1[3] > gm) { gm = acc1[3]; gs = 3; }
        float pg = 1.0f / (expf(acc1[0] - gm) + expf(acc1[1] - gm) + expf(acc1[2] - gm) + expf(acc1[3] - gm));
        gs = __shfl(gs, r32); pg = __shfl(pg, r32);
        float v[4];
#pragma unroll
        for (int i = 0; i < 4; ++i) v[i] = gs == 0 ? acc0[i] : gs == 1 ? acc0[4 + i] : gs == 2 ? acc0[8 + i] : acc0[12 + i];
        float ta = v[0], tb = -INFINITY; int ia = 0, ib = -1;
#pragma unroll
        for (int i = 1; i < 4; ++i) { if (v[i] > ta) { tb = ta; ib = ia; ta = v[i]; ia = i; } else if (v[i] > tb) { tb = v[i]; ib = i; } }
        ia += 4 * hh; ib += 4 * hh;
        const float pa = __shfl_xor(ta, 32), pb = __shfl_xor(tb, 32); const int pia = __shfl_xor(ia, 32), pib = __shfl_xor(ib, 32);
        float l1, l2; int i1, i2;
#define BETTER(x, ix, y, iy) ((x) > (y) || ((x) == (y) && (ix) < (iy)))
        if (BETTER(ta, ia, pa, pia)) { l1 = ta; i1 = ia; if (BETTER(tb, ib, pa, pia)) { l2 = tb; i2 = ib; } else { l2 = pa; i2 = pia; } }
        else { l1 = pa; i1 = pia; if (BETTER(ta, ia, pb, pib)) { l2 = ta; i2 = ia; } else { l2 = pb; i2 = pib; } }
#undef BETTER
        const float w1g = pg / (1.0f + expf(l2 - l1)), w2g = pg - w1g;
        if (hh == 0) { const int e1 = gs * 8 + i1, e2 = gs * 8 + i2;
            eid[2 * tok] = e1; eid[2 * tok + 1] = e2; gwt[2 * tok] = w1g; gwt[2 * tok + 1] = w2g;
            atomicAdd((int*)(lcnt + e1), 1); atomicAdd((int*)(lcnt + e2), 1); }
    }
    __syncthreads();
    if (F.tid < 32) cnt[blockIdx.x * 32 + F.tid] = lcnt[F.tid];
}

__device__ __forceinline__ void phase_assign(Frame& F, int tok0, int tpw) {
    const int* eid = (const int*)(F.ws + WS_EID); const float* gwt = (const float*)(F.ws + WS_GW); const int* cnt = (const int*)(F.ws + WS_CNT);
    int* slot = (int*)(F.ws + WS_SLOT); int* tokrow = (int*)(F.ws + WS_TOKROW); float* wrow = (float*)(F.ws + WS_WROW); int* meta = (int*)(F.ws + WS_META); int* blke = (int*)(F.ws + WS_BLKE);
    LAS int* tot = (LAS int*)F.lds, *mybase = tot + 32, *pstart = tot + 64  , *wtot = tot + 128  , *ptot = tot + 512  , *pbel = tot + 1024  ;
    {
        const int e = F.tid & 31, part = F.tid >> 5, per = (F.G + 15) / 16; int s = 0, mb = 0;
#pragma unroll 8
        for (int q = 0; q < per; ++q) { const int w = part * per + q; if (w < F.G) { const int c = cnt[w * 32 + e]; s += c; if (w < (int)blockIdx.x) mb += c; } }
        ptot[part * 32 + e] = s; pbel[part * 32 + e] = mb; }
    __syncthreads();
    if (F.tid < 32) { int s = 0, mb = 0;
#pragma unroll
        for (int q = 0; q < 16; ++q) { s += ptot[q * 32 + F.tid]; mb += pbel[q * 32 + F.tid]; }
        tot[F.tid] = s; mybase[F.tid] = mb; }
    __syncthreads();
    if (F.tid == 0) { int p = 0; for (int e = 0; e < 32; ++e) { pstart[e] = p; p += ((tot[e] + 255) >> 8) << 8; } pstart[32] = p; }
    __syncthreads();
    int e1 = -1, e2 = -1, tok = 0;
    if (F.tid < tpw) { tok = tok0 + blockIdx.x * tpw + F.tid; e1 = eid[2 * tok]; e2 = eid[2 * tok + 1]; }
    int r1 = 0, r2 = 0; const unsigned long long lt = (F.lane == 0) ? 0ull : (~0ull >> (64 - F.lane));
    for (int e = 0; e < 32; ++e) { const unsigned long long m1 = __ballot(e1 == e), m2 = __ballot(e2 == e); const int below = __popcll(m1 & lt) + __popcll(m2 & lt);
        if (e1 == e) r1 = below; if (e2 == e) r2 = below; if (F.lane == 0) wtot[F.wave * 32 + e] = __popcll(m1) + __popcll(m2); }
    __syncthreads();
    if (F.tid < tpw) {
        int o1 = 0, o2 = 0; for (int w = 0; w < F.wave; ++w) { o1 += wtot[w * 32 + e1]; o2 += wtot[w * 32 + e2]; }
        const int row1 = pstart[e1] + mybase[e1] + o1 + r1, row2 = pstart[e2] + mybase[e2] + o2 + r2;
        tokrow[row1] = tok; tokrow[row2] = tok; wrow[row1] = gwt[2 * tok]; wrow[row2] = gwt[2 * tok + 1]; slot[2 * tok] = row1; slot[2 * tok + 1] = row2;
    }
    if (blockIdx.x < 32) { const int e = blockIdx.x; for (int r = pstart[e] + tot[e] + F.tid; r < pstart[e + 1]; r += NTHR) { tokrow[r] = tok0; wrow[r] = 0.f; } }
    if (blockIdx.x == 0) { const int nblk = pstart[32] >> 8; if (F.tid == 0) meta[0] = nblk;
        for (int bk = F.tid; bk < nblk; bk += NTHR) { int e = 0; for (int q = 1; q < 32; ++q) if (bk * 256 >= pstart[q]) e = q; blke[bk] = e; } }
}

template <bool FINAL>
__device__ __forceinline__ void phase_combine_generic(Frame& F, int layer, const bf16* X, int xrow_off, int row_lo, const bf16* Y, bf16* out16, float* out32) {
    KArgs ap = F.a; const float* modl = (const float*)(F.ws + WS_MOD) + (size_t)layer * 33 * 6144; const int* slot = (const int*)(F.ws + WS_SLOT); bf16* H = (bf16*)(F.ws + WS_H);
    for (int row0 = row_lo + 2 * F.gw; row0 < T; row0 += 2 * F.ngw) {
        u32x2 xw[2][4], p0[2][4], p1[2][4];
#pragma unroll
        for (int rr = 0; rr < 2; ++rr) { const int row = row0 + rr; const bf16* xr = X + (size_t)(row - xrow_off) * D;
            const bf16* y0 = Y + (size_t)slot[2 * row] * D; const bf16* y1 = Y + (size_t)slot[2 * row + 1] * D;
#pragma unroll
#if Y_FP8
            for (int j = 0; j < 4; ++j) { const int col = 4 * F.lane + 256 * j; xw[rr][j] = *(const u32x2*)(xr + col); p0[rr][j].x = *(const unsigned*)((const unsigned char*)Y + (size_t)slot[2 * row] * D + col); p1[rr][j].x = *(const unsigned*)((const unsigned char*)Y + (size_t)slot[2 * row + 1] * D + col); } }
#else
            for (int j = 0; j < 4; ++j) { const int col = 4 * F.lane + 256 * j; xw[rr][j] = *(const u32x2*)(xr + col); p0[rr][j] = *(const u32x2*)(y0 + col); p1[rr][j] = *(const u32x2*)(y1 + col); } }
#endif
#pragma unroll
        for (int rr = 0; rr < 2; ++rr) { const int row = row0 + rr; const float* mr = modl + (size_t)mod_row_of(row) * 6144;
            f32x4 v[4];
#pragma unroll
            for (int j = 0; j < 4; ++j) { const int col = 4 * F.lane + 256 * j; const f32x4 gt = *(const f32x4*)(mr + 5 * 1024 + col);
                const f32x4 x = (f32x4){bflo(xw[rr][j].x), bfhi(xw[rr][j].x), bflo(xw[rr][j].y), bfhi(xw[rr][j].y)};
#if Y_FP8
                const f32x2_t a0 = __builtin_amdgcn_cvt_pk_f32_fp8(p0[rr][j].x, false), a1 = __builtin_amdgcn_cvt_pk_f32_fp8(p0[rr][j].x, true), b0 = __builtin_amdgcn_cvt_pk_f32_fp8(p1[rr][j].x, false), b1 = __builtin_amdgcn_cvt_pk_f32_fp8(p1[rr][j].x, true);
                f32x4 f; f.x = (a0.x + b0.x) * 0.0625f; f.y = (a0.y + b0.y) * 0.0625f; f.z = (a1.x + b1.x) * 0.0625f; f.w = (a1.y + b1.y) * 0.0625f;
#else
                f32x4 f; f.x = bflo(p0[rr][j].x) + bflo(p1[rr][j].x); f.y = bfhi(p0[rr][j].x) + bfhi(p1[rr][j].x); f.z = bflo(p0[rr][j].y) + bflo(p1[rr][j].y); f.w = bfhi(p0[rr][j].y) + bfhi(p1[rr][j].y);
#endif
                v[j] = x + gt * f;
                if (row >= TC) { if (FINAL) *(f32x4*)(out32 + (size_t)(row - TC) * D + col) = v[j];
                                 else { u32x2 w; w.x = cvtpk(v[j].x, v[j].y); w.y = cvtpk(v[j].z, v[j].w); *(u32x2*)(out16 + (size_t)(row - TC) * D + col) = w; } } }
#if C_FP8
            if (!FINAL) modulate_row(v, ap->in[I_NMIX] + (size_t)(layer + 1) * D, (const float*)(F.ws + WS_MOD) + (size_t)(layer + 1) * 33 * 6144 + (size_t)mod_row_of(row) * 6144, 0, nullptr, F.lane, (unsigned char*)H + (size_t)row * D); }
#else
            if (!FINAL) modulate_row(v, ap->in[I_NMIX] + (size_t)(layer + 1) * D, (const float*)(F.ws + WS_MOD) + (size_t)(layer + 1) * 33 * 6144 + (size_t)mod_row_of(row) * 6144, 0, H + (size_t)row * D, F.lane); }
#endif
    }
}

template <bool FINAL>
__device__ __forceinline__ void phase_combine(Frame& F, int layer, const bf16* X, int xrow_off, int row_lo, const bf16* Y, bf16* out16, float* out32) {
    if ((T - row_lo) % (16 * F.G)) { phase_combine_generic<FINAL>(F, layer, X, xrow_off, row_lo, Y, out16, out32); return; }
    KArgs ap = F.a; const float* modl = (const float*)(F.ws + WS_MOD) + (size_t)layer * 33 * 6144; const float* modn = (const float*)(F.ws + WS_MOD) + (size_t)(layer + 1) * 33 * 6144;
    const int* slot = (const int*)(F.ws + WS_SLOT); bf16* H = (bf16*)(F.ws + WS_H);
    const int rpw = (T - row_lo) / F.G, ntrip = rpw / 16, base = row_lo + (int)blockIdx.x * rpw + 2 * F.wave, lc = 4 * F.lane;
    f32x4 gtv[4], shv[4], scv[4], gv[4]; int cur_mr = -1;
    if (!FINAL) {
#pragma unroll
        for (int j = 0; j < 4; ++j) gv[j] = *(const f32x4*)(ap->in[I_NMIX] + (size_t)(layer + 1) * D + lc + 256 * j); }
    int sl[2][2];
#pragma unroll
    for (int rr = 0; rr < 2; ++rr) { sl[rr][0] = slot[2 * (base + rr)]; sl[rr][1] = slot[2 * (base + rr) + 1]; }
#if Y_FP8
    u32x2 dx[2][4]; unsigned d0[2][4], d1[2][4];
#define YLD(p_) __builtin_nontemporal_load((const unsigned*)((const unsigned char*)Y + (size_t)(p_)))
#else
    u32x2 dx[2][4], d0[2][4], d1[2][4];
#endif
#pragma unroll
    for (int rr = 0; rr < 2; ++rr) { const bf16* xr = X + (size_t)(base + rr - xrow_off) * D + lc;
#if Y_FP8
        const size_t y0 = (size_t)sl[rr][0] * D + lc, y1 = (size_t)sl[rr][1] * D + lc;
#pragma unroll
        for (int j = 0; j < 4; ++j) { dx[rr][j] = __builtin_nontemporal_load((const u32x2*)(xr + 256 * j)); d0[rr][j] = YLD(y0 + 256 * j); d1[rr][j] = YLD(y1 + 256 * j); } }
#else
        const bf16* y0 = Y + (size_t)sl[rr][0] * D + lc; const bf16* y1 = Y + (size_t)sl[rr][1] * D + lc;
#pragma unroll
        for (int j = 0; j < 4; ++j) { dx[rr][j] = __builtin_nontemporal_load((const u32x2*)(xr + 256 * j)); d0[rr][j] = *(const u32x2*)(y0 + 256 * j); d1[rr][j] = *(const u32x2*)(y1 + 256 * j); } }
#endif
    if (ntrip > 1) {
#pragma unroll
        for (int rr = 0; rr < 2; ++rr) { sl[rr][0] = slot[2 * (base + 16 + rr)]; sl[rr][1] = slot[2 * (base + 16 + rr) + 1]; } }
    for (int i = 0; i < ntrip; ++i) {
        const int row0 = base + 16 * i; const int mr = mod_row_of(row0);
        if (mr != cur_mr) { cur_mr = mr;
#pragma unroll
            for (int j = 0; j < 4; ++j) { gtv[j] = *(const f32x4*)(modl + (size_t)mr * 6144 + 5 * 1024 + lc + 256 * j) * (Y_FP8 ? 0.0625f : 1.0f);
                if (!FINAL) { shv[j] = *(const f32x4*)(modn + (size_t)mr * 6144 + lc + 256 * j); scv[j] = *(const f32x4*)(modn + (size_t)mr * 6144 + 1024 + lc + 256 * j); } } }
#if Y_FP8
        u32x2 nx[2][4]; unsigned n0[2][4], n1[2][4]; int sn[2][2];
#else
        u32x2 nx[2][4], n0[2][4], n1[2][4]; int sn[2][2];
#endif
        if (i + 1 < ntrip) {
#pragma unroll
            for (int rr = 0; rr < 2; ++rr) { const bf16* xr = X + (size_t)(row0 + 16 + rr - xrow_off) * D + lc;
#if Y_FP8
                const size_t y0 = (size_t)sl[rr][0] * D + lc, y1 = (size_t)sl[rr][1] * D + lc;
#pragma unroll
                for (int j = 0; j < 4; ++j) { nx[rr][j] = __builtin_nontemporal_load((const u32x2*)(xr + 256 * j)); n0[rr][j] = YLD(y0 + 256 * j); n1[rr][j] = YLD(y1 + 256 * j); } } }
#else
                const bf16* y0 = Y + (size_t)sl[rr][0] * D + lc; const bf16* y1 = Y + (size_t)sl[rr][1] * D + lc;
#pragma unroll
                for (int j = 0; j < 4; ++j) { nx[rr][j] = __builtin_nontemporal_load((const u32x2*)(xr + 256 * j)); n0[rr][j] = *(const u32x2*)(y0 + 256 * j); n1[rr][j] = *(const u32x2*)(y1 + 256 * j); } } }
#endif
        if (i + 2 < ntrip) {
#pragma unroll
            for (int rr = 0; rr < 2; ++rr) { sn[rr][0] = slot[2 * (row0 + 32 + rr)]; sn[rr][1] = slot[2 * (row0 + 32 + rr) + 1]; } }
#pragma unroll
        for (int rr = 0; rr < 2; ++rr) { const int row = row0 + rr; f32x4 v[4]; float ss = 0.f;
#pragma unroll
            for (int j = 0; j < 4; ++j) { const int col = lc + 256 * j;
                const f32x4 x = (f32x4){bflo(dx[rr][j].x), bfhi(dx[rr][j].x), bflo(dx[rr][j].y), bfhi(dx[rr][j].y)};
#if Y_FP8
                const f32x2_t a0 = __builtin_amdgcn_cvt_pk_f32_fp8(d0[rr][j], false), a1 = __builtin_amdgcn_cvt_pk_f32_fp8(d0[rr][j], true), b0 = __builtin_amdgcn_cvt_pk_f32_fp8(d1[rr][j], false), b1 = __builtin_amdgcn_cvt_pk_f32_fp8(d1[rr][j], true);
                f32x4 f; f.x = a0.x + b0.x; f.y = a0.y + b0.y; f.z = a1.x + b1.x; f.w = a1.y + b1.y;
#else
                f32x4 f; f.x = bflo(d0[rr][j].x) + bflo(d1[rr][j].x); f.y = bfhi(d0[rr][j].x) + bfhi(d1[rr][j].x); f.z = bflo(d0[rr][j].y) + bflo(d1[rr][j].y); f.w = bfhi(d0[rr][j].y) + bfhi(d1[rr][j].y);
#endif
                v[j] = x + gtv[j] * f;
                ss += (v[j].x * v[j].x + v[j].y * v[j].y) + (v[j].z * v[j].z + v[j].w * v[j].w);
                if (row >= TC) { if (FINAL) __builtin_nontemporal_store(v[j], (f32x4*)(out32 + (size_t)(row - TC) * D + col));
                                 else { u32x2 w; w.x = cvtpk(v[j].x, v[j].y); w.y = cvtpk(v[j].z, v[j].w); __builtin_nontemporal_store(w, (u32x2*)(out16 + (size_t)(row - TC) * D + col)); } } }
            if (!FINAL) { const float r = 1.0f / sqrtf(wave_sum(ss) * (1.0f / D) + EPS);
#pragma unroll
                for (int j = 0; j < 4; ++j) { const f32x4 y = (v[j] * r) * gv[j] * (scv[j] + 1.0f) + shv[j];
#if C_FP8
                    *(unsigned*)((unsigned char*)H + (size_t)row * D + lc + 256 * j) = pk4_fp8(y.x, y.y, y.z, y.w); } } }
#else
                    u32x2 w; w.x = cvtpk(y.x, y.y); w.y = cvtpk(y.z, y.w); *(u32x2*)(H + (size_t)row * D + lc + 256 * j) = w; } } }
#endif
#pragma unroll
        for (int rr = 0; rr < 2; ++rr) { sl[rr][0] = sn[rr][0]; sl[rr][1] = sn[rr][1];
#pragma unroll
            for (int j = 0; j < 4; ++j) { dx[rr][j] = nx[rr][j]; d0[rr][j] = n0[rr][j]; d1[rr][j] = n1[rr][j]; } }
    }
#if Y_FP8
#undef YLD
#endif
}

__device__ __forceinline__ void phase_cstats(Frame& F) {
    const bf16* C = (const bf16*)(F.ws + WS_C); float* rq = (float*)(F.ws + WS_RQ); float* rkv = (float*)(F.ws + WS_RKV);
    const int hl = F.lane & 31, hh = F.lane >> 5;
    for (int row = 2 * F.gw + hh; row < T; row += 2 * F.ngw) {
        const u32x4 q = *(const u32x4*)(C + (size_t)row * 512 + 8 * hl); float sq = 0.f, sk = 0.f;
#pragma unroll
        for (int j = 0; j < 4; ++j) { const float a0 = bflo(q[j]), a1 = bfhi(q[j]); sq += a0 * a0 + a1 * a1; }
        if (hl < 16) { const u32x4 k = *(const u32x4*)(C + (size_t)row * 512 + 256 + 8 * hl);
#pragma unroll
            for (int j = 0; j < 4; ++j) { const float a0 = bflo(k[j]), a1 = bfhi(k[j]); sk += a0 * a0 + a1 * a1; } }
        sq = half_sum(sq); sk = half_sum(sk);
        if (hl == 0) { rq[row] = 1.0f / sqrtf(sq * (1.0f / 256.0f) + EPS); rkv[row] = 1.0f / sqrtf(sk * (1.0f / 128.0f) + EPS); }
    }
}

__device__ __forceinline__ void phase_kvprep(Frame& F) {
    KArgs ap = F.a; const bf16* KV = (const bf16*)(F.ws + WS_KVRAW); const bf16* C = (const bf16*)(F.ws + WS_C); const float* rkv = (const float*)(F.ws + WS_RKV); const float* rope = (const float*)(F.ws + WS_ROPE);
    bf16* Kf = (bf16*)(F.ws + WS_KF); bf16* Vt = (bf16*)(F.ws + WS_VF); const float* gk = ap->in[I_MKQK];
    const int gt = blockIdx.x * NTHR + F.tid, ngt = F.G * NTHR;
    for (int idx = gt; idx < T * NH; idx += ngt) {
        const int row = (idx >> 10) * 64 + (idx & 63), h = (idx >> 6) & 15; const float r = rkv[row];
        int b, pos; if (row < TC) { b = row >> 8; pos = row & 255; } else { b = (row - TC) >> 11; pos = CTXL + ((row - TC) & 2047); }
        const bf16* src = KV + (size_t)row * 2048 + h * 128;
        float kr[32]; float ss = 0.f;
#pragma unroll
        for (int q = 0; q < 8; ++q) { const u32x4 w = *(const u32x4*)(src + 8 * q);
#pragma unroll
            for (int j = 0; j < 4; ++j) { const float a0 = bflo(w[j]) * r, a1 = bfhi(w[j]) * r; ss += a0 * a0 + a1 * a1; } }
#pragma unroll
        for (int q = 0; q < 4; ++q) { const u32x4 w = *(const u32x4*)(C + (size_t)row * 512 + 384 + 8 * q);
#pragma unroll
            for (int j = 0; j < 4; ++j) { kr[8 * q + 2 * j] = bflo(w[j]); kr[8 * q + 2 * j + 1] = bfhi(w[j]); ss += kr[8 * q + 2 * j] * kr[8 * q + 2 * j] + kr[8 * q + 2 * j + 1] * kr[8 * q + 2 * j + 1]; } }
        const float rn = 1.0f / sqrtf(ss * (1.0f / 96.0f) + EPS);
        bf16* kd = Kf + ((size_t)(b * NH + h) * KVLEN + pos) * QK;
        asm volatile("" ::: "memory");
#pragma unroll 1
        for (int q = 0; q < 8; ++q) { const u32x4 w = *(const u32x4*)(src + 8 * q); const f32x4 g0 = *(const f32x4*)(gk + 8 * q), g1 = *(const f32x4*)(gk + 8 * q + 4); const float sc = r * rn; u32x4 o;
            o.x = cvtpk(bflo(w.x) * sc * g0.x, bfhi(w.x) * sc * g0.y); o.y = cvtpk(bflo(w.y) * sc * g0.z, bfhi(w.y) * sc * g0.w); o.z = cvtpk(bflo(w.z) * sc * g1.x, bfhi(w.z) * sc * g1.y); o.w = cvtpk(bflo(w.w) * sc * g1.z, bfhi(w.w) * sc * g1.w);
            *(u32x4*)(kd + 8 * q) = o; }
#pragma unroll
        for (int d = 0; d < 32; ++d) kr[d] = kr[d] * rn * gk[64 + d];
        if (row >= TC) { const int t = pos - CTXL; const int pr = t >> 6, pc = t & 63;
#pragma unroll
            for (int ax = 0; ax < 2; ++ax) { const int p = ax ? pc : pr;
#pragma unroll
                for (int i = 0; i < 8; ++i) { const float cs = rope[(p * 8 + i) * 2], sn = rope[(p * 8 + i) * 2 + 1]; const float x1 = kr[16 * ax + i], x2 = kr[16 * ax + 8 + i];
                    kr[16 * ax + i] = x1 * cs - x2 * sn; kr[16 * ax + 8 + i] = x2 * cs + x1 * sn; } } }
#pragma unroll
        for (int q = 0; q < 4; ++q) { u32x4 w; w.x = cvtpk(kr[8 * q], kr[8 * q + 1]); w.y = cvtpk(kr[8 * q + 2], kr[8 * q + 3]); w.z = cvtpk(kr[8 * q + 4], kr[8 * q + 5]); w.w = cvtpk(kr[8 * q + 6], kr[8 * q + 7]); *(u32x4*)(kd + 64 + 8 * q) = w; }
        const int u = (pos & ~12) | ((pos & 4) << 1) | ((pos & 8) >> 1);
        bf16* vd = Vt + (size_t)(b * NH + h) * VD * KVLEN + u;
#pragma unroll 1
        for (int q = 0; q < 8; ++q) { const u32x4 w = *(const u32x4*)(src + 64 + 8 * q);
#pragma unroll
            for (int j = 0; j < 4; ++j) { const unsigned o = cvtpk(bflo(w[j]) * r, bfhi(w[j]) * r); vd[(size_t)(8 * q + 2 * j) * KVLEN] = (bf16)(o & 0xffffu); vd[(size_t)(8 * q + 2 * j + 1) * KVLEN] = (bf16)(o >> 16); } }
    }
}

__device__ __forceinline__ void phase_attn(Frame& F) {
    KArgs ap = F.a; const bf16* Cb = (const bf16*)(F.ws + WS_C); const bf16* Wq = (const bf16*)(F.ws + WS_WQB); const bf16* Kf = (const bf16*)(F.ws + WS_KF); const bf16* Vt = (const bf16*)(F.ws + WS_VF);
    const float* rope = (const float*)(F.ws + WS_ROPE); bf16* AO = (bf16*)(F.ws + WS_AO); const float* gq = ap->in[I_MQQK]; const float* gk = ap->in[I_MKQK];
    const int tid = F.tid, lane = F.lane, r32 = lane & 31, hi = lane >> 5, wave = F.wave;
    constexpr float SC = 0.10206207261596577f * 1.4426950408889634f;
    float gqm = 0.f, gkm = 0.f;
    for (int d = 0; d < QK; ++d) { gqm = fmaxf(gqm, fabsf(gq[d])); gkm = fmaxf(gkm, fabsf(gk[d])); }
    const float negm = -(9.797958971132712f * 1.4426950408889634f) * gqm * gkm;
#if ATT_FP8
    const int sr = tid >> 3, scn = tid & 7;
    const int dKA = sr * 128 + ((scn ^ ((sr >> 1) & 7)) << 4);
    const int t2 = tid - 256, br = t2 >> 2, bc = t2 & 3;
    const int dKB = 8192 + br * 64 + ((bc ^ ((br >> 2) & 3)) << 4);
    constexpr int ABUF = 12288;
#else
    const int sr = tid >> 3, scn = tid & 7;
    const int dKA = sr * 128 + ((scn ^ ((sr >> 1) & 7)) << 4), dVT = 12288 + dKA;
    const int t2 = tid - 256, br = t2 >> 2, bc = t2 & 3;
    const int dKB = 8192 + br * 64 + ((bc ^ ((br >> 2) & 3)) << 4);
    constexpr int ABUF = 20480;
#endif
    const int sw7 = (r32 >> 1) & 7, sw3 = (r32 >> 2) & 3;
    constexpr int OST_OFF = 40960 + 49152;
    constexpr int WQ_OFF = 40960;
    int h_staged = -1;
    for (int unit = blockIdx.x; unit < NB * NH * 8; unit += F.G) {
        const int b = unit >> 7, h = (unit >> 3) & 15, qb = unit & 7; const int tq = qb * 256 + wave * 32 + r32; const int lrow = b * SEQ + tq;
        if (h != h_staged) {
            __syncthreads();
            int tidq = tid; asm volatile("" : "+v"(tidq));
#pragma unroll
            for (int i = 0; i < 6; ++i) { const int p = tidq + 512 * i, wrow = p >> 5, wch = p & 31;
                *(LAS u32x4*)(F.lds + WQ_OFF + wrow * 512 + ((wch ^ (wrow & 15)) << 4)) = *(const u32x4*)(Wq + ((size_t)h * 96 + wrow) * 256 + wch * 8); }
            h_staged = h;
            __syncthreads();
        }
#if ATT_FP8
        const unsigned char* Kh8 = (const unsigned char*)Kf + (size_t)(b * NH + h) * KVLEN * 128; const unsigned char* Vh8 = (const unsigned char*)Vt + (size_t)(b * NH + h) * VD * KVLEN;
        const unsigned char* gKA = Kh8 + (size_t)sr * 128 + scn * 16; const unsigned char* gKB = Vh8 + (size_t)br * KVLEN + bc * 16;
        u32x4 rKA = *(const u32x4*)gKA, rKB = (u32x4){0u, 0u, 0u, 0u};
        if (tid >= 256) rKB = *(const u32x4*)gKB;
#else
        const bf16* Kh = Kf + (size_t)(b * NH + h) * KVLEN * QK; const bf16* Vh = Vt + (size_t)(b * NH + h) * VD * KVLEN;
        const bf16* gKA = Kh + (size_t)sr * QK + scn * 8; const bf16* gKB = Kh + (size_t)br * QK + 64 + bc * 8; const bf16* gVT = Vh + (size_t)sr * KVLEN + scn * 8;
        u32x4 rKA = *(const u32x4*)gKA, rVT = *(const u32x4*)gVT, rKB = (u32x4){0u, 0u, 0u, 0u};
        if (tid >= 256) rKB = *(const u32x4*)gKB;
#endif
        typedef int v8i_t __attribute__((ext_vector_type(8))); typedef int v4i_t __attribute__((ext_vector_type(4)));
        bf16x8 qf[6]; v8i_t qf8[2]; (void)qf; (void)qf8;
        {
            const bf16* crow_p = Cb + (size_t)(TC + lrow) * 512 + 8 * hi;
            f32x16 qa[3]; qa[0] = (f32x16){}; qa[1] = (f32x16){}; qa[2] = (f32x16){};
            float ssc = 0.f;
            int r32q = r32; asm volatile("" : "+v"(r32q));
            const LAS unsigned char* wbase = F.lds + WQ_OFF + r32q * 512;
#pragma unroll
            for (int kh = 0; kh < 2; ++kh) {
                u32x4 cw[8];
#pragma unroll
                for (int k8 = 0; k8 < 8; ++k8) cw[k8] = *(const u32x4*)(crow_p + 16 * (8 * kh + k8));
#pragma unroll
                for (int k8 = 0; k8 < 8; ++k8) { const int ks = 8 * kh + k8; const bf16x8 cf = __builtin_bit_cast(bf16x8, cw[k8]);
#pragma unroll
                    for (int j = 0; j < 4; ++j) { const float a0 = bflo(cw[k8][j]), a1 = bfhi(cw[k8][j]); ssc += a0 * a0 + a1 * a1; }
#pragma unroll
                    for (int nt = 0; nt < 3; ++nt) { const bf16x8 wf = *(const LAS bf16x8*)(wbase + nt * 32 * 512 + (((2 * ks + hi) ^ (r32q & 15)) << 4)); qa[nt] = __builtin_amdgcn_mfma_f32_32x32x16_bf16(wf, cf, qa[nt], 0, 0, 0); }
                    if (k8 & 1) __builtin_amdgcn_sched_barrier(0); }
                asm volatile("" ::: "memory");
            }
            ssc += __shfl_xor(ssc, 32);
            const float r = 1.0f / sqrtf(ssc * (1.0f / 256.0f) + EPS);
            float ss = 0.f;
#pragma unroll
            for (int nt = 0; nt < 3; ++nt)
#pragma unroll
                for (int i = 0; i < 16; ++i) { qa[nt][i] *= r; ss += qa[nt][i] * qa[nt][i]; }
            ss += __shfl_xor(ss, 32);
            const float rn = 1.0f / sqrtf(ss * (1.0f / 96.0f) + EPS);
#pragma unroll
            for (int nt = 0; nt < 3; ++nt)
#pragma unroll
                for (int i = 0; i < 16; ++i) qa[nt][i] *= rn * gq[32 * nt + 16 * (i >> 3) + 8 * hi + (i & 7)];
            const int pr = tq >> 6, pc = tq & 63;
#pragma unroll
            for (int ax = 0; ax < 2; ++ax) { const int p = ax ? pc : pr;
#pragma unroll
                for (int j = 0; j < 8; ++j) { const float mine = qa[2][8 * ax + j]; const float other = __shfl_xor(mine, 32); const float cs = rope[(p * 8 + j) * 2], sn = rope[(p * 8 + j) * 2 + 1];
                    qa[2][8 * ax + j] = mine * cs + (hi ? other : -other) * sn; } }
#if ATT_FP8
#pragma unroll
            for (int sx = 0; sx < 2; ++sx) { v8i_t w;
#pragma unroll
                for (int q4 = 0; q4 < 4; ++q4) w[q4] = (int)pk4_fp8(qa[2 * sx][4 * q4] * (8.f * SC), qa[2 * sx][4 * q4 + 1] * (8.f * SC), qa[2 * sx][4 * q4 + 2] * (8.f * SC), qa[2 * sx][4 * q4 + 3] * (8.f * SC));
#pragma unroll
                for (int q4 = 0; q4 < 4; ++q4) w[4 + q4] = sx ? 0 : (int)pk4_fp8(qa[1][4 * q4] * (8.f * SC), qa[1][4 * q4 + 1] * (8.f * SC), qa[1][4 * q4 + 2] * (8.f * SC), qa[1][4 * q4 + 3] * (8.f * SC));
                qf8[sx] = w; }
#else
#pragma unroll
            for (int ks = 0; ks < 6; ++ks) { const int nt = ks >> 1, o = 8 * (ks & 1); u32x4 w;
                w.x = cvtpk(qa[nt][o] * SC, qa[nt][o + 1] * SC); w.y = cvtpk(qa[nt][o + 2] * SC, qa[nt][o + 3] * SC); w.z = cvtpk(qa[nt][o + 4] * SC, qa[nt][o + 5] * SC); w.w = cvtpk(qa[nt][o + 6] * SC, qa[nt][o + 7] * SC);
                qf[ks] = __builtin_bit_cast(bf16x8, w); }
#endif
        }
        f32x16 o0 = {}, o1 = {}; float lsum = 0.f;
#if ATT_FP8
        *(LAS u32x4*)(F.lds + dKA) = rKA; if (tid >= 256) *(LAS u32x4*)(F.lds + dKB) = rKB;
        __syncthreads();
        constexpr int NT = KVLEN / 64;
        f32x16 negv;
#pragma unroll
        for (int r = 0; r < 16; ++r) negv[r] = -1.0f;
        asm volatile("" : "+v"(negv));
        const int oK0 = r32 * 128 + (((0 + 2 * hi) ^ sw7) << 4), oK1 = r32 * 128 + (((1 + 2 * hi) ^ sw7) << 4), oK2 = r32 * 128 + (((4 + 2 * hi) ^ sw7) << 4), oK3 = r32 * 128 + (((5 + 2 * hi) ^ sw7) << 4);
        const int oV0 = 8192 + r32 * 64 + (((2 * hi) ^ sw3) << 4), oV1 = 8192 + r32 * 64 + (((2 * hi + 1) ^ sw3) << 4);
#define LD32(p0, p1) __builtin_shufflevector(*(const LAS v4i_t*)(p0), *(const LAS v4i_t*)(p1), 0, 1, 2, 3, 4, 5, 6, 7)
        for (int t = 0; t < NT; ++t) {
            const LAS unsigned char* buf = F.lds + (t & 1) * ABUF;
            if (t + 1 < NT) { rKA = *(const u32x4*)(gKA + (size_t)(t + 1) * 64 * 128); if (tid >= 256) rKB = *(const u32x4*)(gKB + (t + 1) * 64); }
            const v8i_t k00 = LD32(buf + oK0, buf + oK1), k01 = LD32(buf + oK2, buf + oK3), k10 = LD32(buf + oK0 + 4096, buf + oK1 + 4096), k11 = LD32(buf + oK2 + 4096, buf + oK3 + 4096);
            f32x16 s0 = __builtin_amdgcn_mfma_scale_f32_32x32x64_f8f6f4(k00, qf8[0], negv, 0, 0, 0, 0x7f7f7f7f, 0, 0x7c7c7c7c);
            f32x16 s1 = __builtin_amdgcn_mfma_scale_f32_32x32x64_f8f6f4(k10, qf8[0], negv, 0, 0, 0, 0x7f7f7f7f, 0, 0x7c7c7c7c);
            s0 = __builtin_amdgcn_mfma_scale_f32_32x32x64_f8f6f4(k01, qf8[1], s0, 0, 0, 0, 0x7f7f7f7f, 0, 0x7c7c7c7c);
            s1 = __builtin_amdgcn_mfma_scale_f32_32x32x64_f8f6f4(k11, qf8[1], s1, 0, 0, 0, 0x7f7f7f7f, 0, 0x7c7c7c7c);
            const v8i_t v0 = LD32(buf + oV0, buf + oV1), v1 = LD32(buf + oV0 + 2048, buf + oV1 + 2048);
            float ls = 0.f;
#pragma unroll
            for (int r = 0; r < 16; ++r) { s0[r] = __builtin_amdgcn_exp2f(s0[r]); s1[r] = __builtin_amdgcn_exp2f(s1[r]); ls += s0[r] + s1[r]; }
            lsum += ls;
            v8i_t pw;
#pragma unroll
            for (int q4 = 0; q4 < 4; ++q4) { pw[q4] = (int)pk4_fp8(s0[4 * q4], s0[4 * q4 + 1], s0[4 * q4 + 2], s0[4 * q4 + 3]); pw[4 + q4] = (int)pk4_fp8(s1[4 * q4], s1[4 * q4 + 1], s1[4 * q4 + 2], s1[4 * q4 + 3]); }
            o0 = __builtin_amdgcn_mfma_scale_f32_32x32x64_f8f6f4(v0, pw, o0, 0, 0, 0, 0x7f7f7f7f, 0, 0x7f7f7f7f);
            o1 = __builtin_amdgcn_mfma_scale_f32_32x32x64_f8f6f4(v1, pw, o1, 0, 0, 0, 0x7f7f7f7f, 0, 0x7f7f7f7f);
            if (t + 1 < NT) { LAS unsigned char* nb = F.lds + ((t + 1) & 1) * ABUF; *(LAS u32x4*)(nb + dKA) = rKA; if (tid >= 256) *(LAS u32x4*)(nb + dKB) = rKB; }
            __syncthreads();
        }
#undef LD32
#else
        *(LAS u32x4*)(F.lds + dKA) = rKA; *(LAS u32x4*)(F.lds + dVT) = rVT; if (tid >= 256) *(LAS u32x4*)(F.lds + dKB) = rKB;
        __syncthreads();
        constexpr int NT = KVLEN / 64;
        for (int t = 0; t < NT; ++t) {
            LAS unsigned char* buf = F.lds + (t & 1) * 20480;
            if (t + 1 < NT) { rKA = *(const u32x4*)(gKA + (size_t)(t + 1) * 64 * QK); rVT = *(const u32x4*)(gVT + (t + 1) * 64); if (tid >= 256) rKB = *(const u32x4*)(gKB + (size_t)(t + 1) * 64 * QK); }
            f32x16 s0, s1;
#pragma unroll
            for (int r = 0; r < 16; ++r) { s0[r] = negm; s1[r] = negm; }
#pragma unroll
            for (int ks = 0; ks < 6; ++ks) {
                const int off = (ks < 4) ? (r32 * 128 + (((2 * ks + hi) ^ sw7) << 4)) : (8192 + r32 * 64 + (((2 * (ks - 4) + hi) ^ sw3) << 4));
                const bf16x8 a0 = *(const LAS bf16x8*)(buf + off), a1 = *(const LAS bf16x8*)(buf + off + ((ks < 4) ? 4096 : 2048));
                s0 = __builtin_amdgcn_mfma_f32_32x32x16_bf16(a0, qf[ks], s0, 0, 0, 0); s1 = __builtin_amdgcn_mfma_f32_32x32x16_bf16(a1, qf[ks], s1, 0, 0, 0);
            }
            float ls = 0.f;
#pragma unroll
            for (int r = 0; r < 16; ++r) { s0[r] = __builtin_amdgcn_exp2f(s0[r]); s1[r] = __builtin_amdgcn_exp2f(s1[r]); ls += s0[r] + s1[r]; }
            lsum += ls;
            bf16x8 pw[4];
            { u32x4 w;
              w.x = cvtpk(s0[0], s0[1]); w.y = cvtpk(s0[2], s0[3]); w.z = cvtpk(s0[4], s0[5]); w.w = cvtpk(s0[6], s0[7]); pw[0] = __builtin_bit_cast(bf16x8, w);
              w.x = cvtpk(s0[8], s0[9]); w.y = cvtpk(s0[10], s0[11]); w.z = cvtpk(s0[12], s0[13]); w.w = cvtpk(s0[14], s0[15]); pw[1] = __builtin_bit_cast(bf16x8, w);
              w.x = cvtpk(s1[0], s1[1]); w.y = cvtpk(s1[2], s1[3]); w.z = cvtpk(s1[4], s1[5]); w.w = cvtpk(s1[6], s1[7]); pw[2] = __builtin_bit_cast(bf16x8, w);
              w.x = cvtpk(s1[8], s1[9]); w.y = cvtpk(s1[10], s1[11]); w.z = cvtpk(s1[12], s1[13]); w.w = cvtpk(s1[14], s1[15]); pw[3] = __builtin_bit_cast(bf16x8, w); }
#pragma unroll
            for (int s = 0; s < 4; ++s) {
                const int off = 12288 + r32 * 128 + (((2 * s + hi) ^ sw7) << 4);
                const bf16x8 v0 = *(const LAS bf16x8*)(buf + off), v1 = *(const LAS bf16x8*)(buf + off + 4096);
                o0 = __builtin_amdgcn_mfma_f32_32x32x16_bf16(v0, pw[s], o0, 0, 0, 0); o1 = __builtin_amdgcn_mfma_f32_32x32x16_bf16(v1, pw[s], o1, 0, 0, 0);
            }
            if (t + 1 < NT) { LAS unsigned char* nb = F.lds + ((t + 1) & 1) * 20480; *(LAS u32x4*)(nb + dKA) = rKA; *(LAS u32x4*)(nb + dVT) = rVT; if (tid >= 256) *(LAS u32x4*)(nb + dKB) = rKB; }
            __syncthreads();
        }
#endif
        lsum += __shfl_xor(lsum, 32);
        const float il = 1.0f / lsum;
        LAS unsigned char* ost = F.lds + OST_OFF + wave * 4608;
#pragma unroll
        for (int g = 0; g < 4; ++g) { u32x2 w0, w1; w0.x = cvtpk(o0[4 * g] * il, o0[4 * g + 1] * il); w0.y = cvtpk(o0[4 * g + 2] * il, o0[4 * g + 3] * il); w1.x = cvtpk(o1[4 * g] * il, o1[4 * g + 1] * il); w1.y = cvtpk(o1[4 * g + 2] * il, o1[4 * g + 3] * il);
            *(LAS u32x2*)(ost + r32 * 144 + (8 * g + 4 * hi) * 2) = w0; *(LAS u32x2*)(ost + r32 * 144 + (32 + 8 * g + 4 * hi) * 2) = w1; }
        asm volatile("s_waitcnt lgkmcnt(0)" ::: "memory");
        bf16* dstw = AO + ((size_t)b * SEQ + qb * 256 + wave * 32) * D + h * 64;
#pragma unroll
        for (int i = 0; i < 4; ++i) { const int row = 8 * i + (lane >> 3), ch = lane & 7; *(u32x4*)(dstw + (size_t)row * D + ch * 8) = *(const LAS u32x4*)(ost + row * 144 + ch * 16); }
    }
}

__device__ __forceinline__ void phase_attn8x2(Frame& F) {
    KArgs ap = F.a; const bf16* Cb = (const bf16*)(F.ws + WS_C); const bf16* Wq = (const bf16*)(F.ws + WS_WQB); const unsigned char* Kf8 = (const unsigned char*)(F.ws + WS_KF); const unsigned char* Vt8 = (const unsigned char*)(F.ws + WS_VF);
    const float* rope = (const float*)(F.ws + WS_ROPE); bf16* AO = (bf16*)(F.ws + WS_AO); const float* gq = ap->in[I_MQQK];
    const int wave = F.wave;
    constexpr float SC8 = 8.0f * 0.10206207261596577f * 1.4426950408889634f;
    typedef int v8i_t __attribute__((ext_vector_type(8))); typedef int v4i_t __attribute__((ext_vector_type(4)));
    constexpr int KPITCH = 144, VPITCH = 80, VOFF = 64 * KPITCH, ABUF = VOFF + 64 * VPITCH;
    constexpr int WQ_OFF = 2 * ABUF, TAB_OFF = WQ_OFF + 49152, OST_OFF = TAB_OFF + 4608;
    static_assert(OST_OFF + 8 * 8192 <= MISC_OFF, "attention LDS map");
    int h_staged = -1;
    for (int unit = blockIdx.x; unit < NB * NH * 4; unit += F.G) {
        const int b = unit >> 6, h = (unit >> 2) & 15, qb2 = unit & 3;
        int lane = (int)__builtin_amdgcn_mbcnt_hi(~0u, __builtin_amdgcn_mbcnt_lo(~0u, 0u)); asm volatile("" : "+v"(lane));
        const int tid = wave * 64 + lane, tidu = tid, r32 = lane & 31, hi = lane >> 5, r32u = r32, hiu = hi;
        const int sr = tidu >> 3, scn = tidu & 7;
        const int dKA = sr * KPITCH + scn * 16;
        const int t2 = tidu - 256, br = t2 >> 2, bc = t2 & 3;
        const int dKB = VOFF + br * VPITCH + bc * 16;
        if (h != h_staged) {
            __syncthreads();
            int tidq = tid; asm volatile("" : "+v"(tidq));
#if Q_FP8
#pragma unroll
            for (int i = 0; i < 3; ++i) { const int p = tidq + 512 * i, wrow = p >> 4, wch = p & 15;
                *(LAS u32x4*)(F.lds + WQ_OFF + wrow * 272 + wch * 16) = *(const u32x4*)((const unsigned char*)Wq + ((size_t)h * 96 + wrow) * 256 + wch * 16); }
#else
#pragma unroll
            for (int i = 0; i < 6; ++i) { const int p = tidq + 512 * i, wrow = p >> 5, wch = p & 31;
                *(LAS u32x4*)(F.lds + WQ_OFF + wrow * 512 + ((wch ^ (wrow & 15)) << 4)) = *(const u32x4*)(Wq + ((size_t)h * 96 + wrow) * 256 + wch * 8); }
#endif
            for (int i = tidq; i < 96 + 1024; i += NTHR) ((LAS float*)(F.lds + TAB_OFF))[i] = (i < 96) ? gq[i] * SC8 : rope[i - 96];
            h_staged = h;
            __syncthreads();
        }
        const unsigned char* Kh8 = Kf8 + (size_t)(b * NH + h) * KVLEN * 128; const unsigned char* Vh8 = Vt8 + (size_t)(b * NH + h) * VD * KVLEN;
        const unsigned char* gKA = Kh8 + (size_t)sr * 128 + scn * 16; const unsigned char* gKB = Vh8 + (size_t)br * KVLEN + bc * 16;
        u32x4 rKA = *(const u32x4*)gKA, rKB = (u32x4){0u, 0u, 0u, 0u};
        if (tid >= 256) rKB = *(const u32x4*)gKB;
        LAS unsigned char* qst = F.lds + OST_OFF + wave * 8192;
#pragma unroll 1
        for (int u = 0; u < 2; ++u) {
            int r32q = r32, hiq = hi; asm volatile("" : "+v"(r32q), "+v"(hiq));
            const int tq = qb2 * 512 + u * 256 + wave * 32 + r32q; const int lrow = b * SEQ + tq;
            const bf16* crow_p = Cb + (size_t)(TC + lrow) * 512 + 8 * hiq;
            f32x16 qa[3]; qa[0] = (f32x16){}; qa[1] = (f32x16){}; qa[2] = (f32x16){};
            float ssc = 0.f;
            const LAS unsigned char* wbase = F.lds + WQ_OFF + r32q * 512;
#if Q_FP8
            const unsigned char* c8row = (const unsigned char*)(F.ws + WS_C8) + (size_t)(TC + lrow) * 256 + 32 * hiq;
            v8i_t cf8[4];
#pragma unroll
            for (int kb = 0; kb < 4; ++kb) cf8[kb] = __builtin_shufflevector(*(const v4i_t*)(c8row + 64 * kb), *(const v4i_t*)(c8row + 64 * kb + 16), 0, 1, 2, 3, 4, 5, 6, 7);
            { const f32x4 q4 = *(const f32x4*)((const float*)(F.ws + WS_SSQ) + (size_t)(TC + lrow) * 4); ssc = 0.5f * ((q4.x + q4.y) + (q4.z + q4.w)); }
            const LAS unsigned char* wb8 = F.lds + WQ_OFF + r32q * 272 + 32 * hiq;
#pragma unroll
            for (int kb = 0; kb < 4; ++kb) {
#pragma unroll
                for (int nt = 0; nt < 3; ++nt) { const v8i_t wf8 = __builtin_shufflevector(*(const LAS v4i_t*)(wb8 + nt * 32 * 272 + 64 * kb), *(const LAS v4i_t*)(wb8 + nt * 32 * 272 + 64 * kb + 16), 0, 1, 2, 3, 4, 5, 6, 7);
                    qa[nt] = __builtin_amdgcn_mfma_scale_f32_32x32x64_f8f6f4(wf8, cf8[kb], qa[nt], 0, 0, 0, 0x7f7f7f7f, 0, 0x7f7f7f7f); }
                __builtin_amdgcn_sched_barrier(0); }
#else
            u32x4 cwa[16];
#pragma unroll
            for (int k16 = 0; k16 < 16; ++k16) cwa[k16] = *(const u32x4*)(crow_p + 16 * k16);
            { const f32x4 q4 = *(const f32x4*)((const float*)(F.ws + WS_SSQ) + (size_t)(TC + lrow) * 4); ssc = 0.5f * ((q4.x + q4.y) + (q4.z + q4.w)); }
#pragma unroll
            for (int kq = 0; kq < 4; ++kq) {
#pragma unroll
                for (int k4 = 0; k4 < 4; ++k4) { const int ks = 4 * kq + k4; const bf16x8 cf = __builtin_bit_cast(bf16x8, cwa[ks]);
#pragma unroll
                    for (int nt = 0; nt < 3; ++nt) { const bf16x8 wf = *(const LAS bf16x8*)(wbase + nt * 32 * 512 + (((2 * ks + hiq) ^ (r32q & 15)) << 4)); qa[nt] = __builtin_amdgcn_mfma_f32_32x32x16_bf16(wf, cf, qa[nt], 0, 0, 0); }
                    __builtin_amdgcn_sched_barrier(0); }
                asm volatile("" ::: "memory");
            }
#endif
            ssc += __shfl_xor(ssc, 32);
            const float r = (Q_FP8 ? (1.0f / 512.0f) : 1.0f) / sqrtf(ssc * (1.0f / 256.0f) + EPS);
            float ss = 0.f;
#pragma unroll
            for (int nt = 0; nt < 3; ++nt)
#pragma unroll
                for (int i = 0; i < 16; ++i) ss += qa[nt][i] * qa[nt][i];
            ss += __shfl_xor(ss, 32);
            const float rn = r / sqrtf(ss * (r * r) * (1.0f / 96.0f) + EPS);
#pragma unroll
            for (int nt = 0; nt < 3; ++nt)
#pragma unroll
                for (int g4 = 0; g4 < 4; ++g4) { const f32x4 t4 = *(const LAS f32x4*)(F.lds + TAB_OFF + (32 * nt + 16 * (g4 >> 1) + 8 * hiq + 4 * (g4 & 1)) * 4);
                    qa[nt][4 * g4] *= rn * t4.x; qa[nt][4 * g4 + 1] *= rn * t4.y; qa[nt][4 * g4 + 2] *= rn * t4.z; qa[nt][4 * g4 + 3] *= rn * t4.w; }
            const int pr = tq >> 6, pc = tq & 63;
#pragma unroll
            for (int ax = 0; ax < 2; ++ax) { const int p = ax ? pc : pr;
#pragma unroll
                for (int j = 0; j < 8; ++j) { const float mine = qa[2][8 * ax + j]; const float other = __shfl_xor(mine, 32); const f32x2_t csn = *(const LAS f32x2_t*)(F.lds + TAB_OFF + 384 + (p * 8 + j) * 8);
                    qa[2][8 * ax + j] = mine * csn.x + (hiq ? other : -other) * csn.y; } }
#pragma unroll
            for (int sx = 0; sx < 2; ++sx) { v8i_t w;
#pragma unroll
                for (int q4 = 0; q4 < 4; ++q4) w[q4] = (int)pk4_fp8(qa[2 * sx][4 * q4], qa[2 * sx][4 * q4 + 1], qa[2 * sx][4 * q4 + 2], qa[2 * sx][4 * q4 + 3]);
#pragma unroll
                for (int q4 = 0; q4 < 4; ++q4) w[4 + q4] = sx ? 0 : (int)pk4_fp8(qa[1][4 * q4], qa[1][4 * q4 + 1], qa[1][4 * q4 + 2], qa[1][4 * q4 + 3]);
                *(LAS v4i_t*)(qst + (u * 2 + sx) * 2048 + lane * 32) = __builtin_shufflevector(w, w, 0, 1, 2, 3); *(LAS v4i_t*)(qst + (u * 2 + sx) * 2048 + lane * 32 + 16) = __builtin_shufflevector(w, w, 4, 5, 6, 7); }
        }
        asm volatile("s_waitcnt lgkmcnt(0)" ::: "memory");
        v8i_t qf8[2][2];
#pragma unroll
        for (int u = 0; u < 2; ++u)
#pragma unroll
            for (int sx = 0; sx < 2; ++sx) qf8[u][sx] = __builtin_shufflevector(*(const LAS v4i_t*)(qst + (u * 2 + sx) * 2048 + lane * 32), *(const LAS v4i_t*)(qst + (u * 2 + sx) * 2048 + lane * 32 + 16), 0, 1, 2, 3, 4, 5, 6, 7);
        f32x16 o[2][2]; f32x4 lacc[2]; lacc[0] = (f32x4){0.f, 0.f, 0.f, 0.f}; lacc[1] = lacc[0];
        v8i_t sel; { const int one4 = (lane == 0 || lane == 32 || lane == 17 || lane == 49) ? 0x38383838 : 0;
#pragma unroll
            for (int i = 0; i < 8; ++i) sel[i] = one4; }
#pragma unroll
        for (int u = 0; u < 2; ++u) { o[u][0] = (f32x16){}; o[u][1] = (f32x16){}; }
        *(LAS u32x4*)(F.lds + dKA) = rKA; if (tid >= 256) *(LAS u32x4*)(F.lds + dKB) = rKB;
        __syncthreads();
        constexpr int NT = KVLEN / 64;
        const f32x16 zero16 = {};
        const int oK = r32u * KPITCH + 32 * hiu, oV = VOFF + r32u * VPITCH + 32 * hiu;
#define LD32(p0, p1) __builtin_shufflevector(*(const LAS v4i_t*)(p0), *(const LAS v4i_t*)(p1), 0, 1, 2, 3, 4, 5, 6, 7)
        if (wave >= 4) __builtin_amdgcn_s_setprio(1);
        for (int t = 0; t < NT; ++t) {
            const LAS unsigned char* buf = F.lds + (t & 1) * ABUF;
            if (t + 1 < NT) { rKA = *(const u32x4*)(gKA + (size_t)(t + 1) * 64 * 128); if (tid >= 256) rKB = *(const u32x4*)(gKB + (t + 1) * 64); }
            const v8i_t k00 = LD32(buf + oK, buf + oK + 16), k01 = LD32(buf + oK + 64, buf + oK + 80), k10 = LD32(buf + oK + 32 * KPITCH, buf + oK + 32 * KPITCH + 16), k11 = LD32(buf + oK + 32 * KPITCH + 64, buf + oK + 32 * KPITCH + 80);
            const v8i_t v0 = LD32(buf + oV, buf + oV + 16), v1 = LD32(buf + oV + 32 * VPITCH, buf + oV + 32 * VPITCH + 16);
            f32x16 sa[2], sb[2]; v8i_t pw[2];
#define QKM(acc, kf, qf, cin) acc = __builtin_amdgcn_mfma_scale_f32_32x32x64_f8f6f4(kf, qf, cin, 0, 0, 0, 0x7f7f7f7f, 0, 0x7c7c7c7c)
#define EXP8(v, lo) do { _Pragma("unroll") for (int r = (lo); r < (lo) + 8; ++r) v[r] = __builtin_amdgcn_exp2f(v[r]); } while (0)
#define PACK(u, v, lo, dst0) do { _Pragma("unroll") for (int q4 = (lo) / 4; q4 < (lo) / 4 + 2; ++q4) pw[u][(dst0) + q4] = (int)pk4_fp8(v[4 * q4], v[4 * q4 + 1], v[4 * q4 + 2], v[4 * q4 + 3]); } while (0)
#define SB() __builtin_amdgcn_sched_barrier(0)
            QKM(sa[0], k00, qf8[0][0], zero16); QKM(sb[0], k10, qf8[0][0], zero16); QKM(sa[0], k01, qf8[0][1], sa[0]); QKM(sb[0], k11, qf8[0][1], sb[0]); SB();
            QKM(sa[1], k00, qf8[1][0], zero16); EXP8(sa[0], 0); SB();
            QKM(sb[1], k10, qf8[1][0], zero16); EXP8(sa[0], 8); SB();
            QKM(sa[1], k01, qf8[1][1], sa[1]); EXP8(sb[0], 0); PACK(0, sa[0], 0, 0); SB();
            QKM(sb[1], k11, qf8[1][1], sb[1]); EXP8(sb[0], 8); PACK(0, sa[0], 8, 0); SB();
            PACK(0, sb[0], 0, 4); PACK(0, sb[0], 8, 4); SB();
            o[0][0] = __builtin_amdgcn_mfma_scale_f32_32x32x64_f8f6f4(v0, pw[0], o[0][0], 0, 0, 0, 0x7f7f7f7f, 0, 0x7f7f7f7f); EXP8(sa[1], 0); SB();
            o[0][1] = __builtin_amdgcn_mfma_scale_f32_32x32x64_f8f6f4(v1, pw[0], o[0][1], 0, 0, 0, 0x7f7f7f7f, 0, 0x7f7f7f7f); EXP8(sa[1], 8); SB();
            lacc[0] = __builtin_amdgcn_mfma_scale_f32_16x16x128_f8f6f4(sel, pw[0], lacc[0], 0, 0, 0, 0x7f7f7f7f, 0, 0x7f7f7f7f); EXP8(sb[1], 0); PACK(1, sa[1], 0, 0); SB();
            EXP8(sb[1], 8); PACK(1, sa[1], 8, 0); PACK(1, sb[1], 0, 4); PACK(1, sb[1], 8, 4); SB();
            o[1][0] = __builtin_amdgcn_mfma_scale_f32_32x32x64_f8f6f4(v0, pw[1], o[1][0], 0, 0, 0, 0x7f7f7f7f, 0, 0x7f7f7f7f);
            o[1][1] = __builtin_amdgcn_mfma_scale_f32_32x32x64_f8f6f4(v1, pw[1], o[1][1], 0, 0, 0, 0x7f7f7f7f, 0, 0x7f7f7f7f);
            lacc[1] = __builtin_amdgcn_mfma_scale_f32_16x16x128_f8f6f4(sel, pw[1], lacc[1], 0, 0, 0, 0x7f7f7f7f, 0, 0x7f7f7f7f);
#undef QKM
#undef EXP8
#undef PACK
#undef SB
            if (t + 1 < NT) { LAS unsigned char* nb = F.lds + ((t + 1) & 1) * ABUF; *(LAS u32x4*)(nb + dKA) = rKA; if (tid >= 256) *(LAS u32x4*)(nb + dKB) = rKB; }
            __syncthreads();
        }
        __builtin_amdgcn_s_setprio(0);
#undef LD32
        int lane_e = (int)__builtin_amdgcn_mbcnt_hi(~0u, __builtin_amdgcn_mbcnt_lo(~0u, 0u)); asm volatile("" : "+v"(lane_e)); const int r32e = lane_e & 31, hie = lane_e >> 5;
        LAS unsigned char* ost = F.lds + OST_OFF + wave * 8192;
#pragma unroll
        for (int u = 0; u < 2; ++u) {
            const float l0_ = __shfl(lacc[u][0], r32e & 15), l1_ = __shfl(lacc[u][1], r32e & 15); const float l = (r32e < 16) ? l0_ : l1_;
#if AO_FP8
            const float il = 16.0f / l;
#pragma unroll
            for (int g = 0; g < 4; ++g) { *(LAS unsigned*)(ost + r32e * 80 + 8 * g + 4 * hie) = pk4_fp8(o[u][0][4 * g] * il, o[u][0][4 * g + 1] * il, o[u][0][4 * g + 2] * il, o[u][0][4 * g + 3] * il);
                *(LAS unsigned*)(ost + r32e * 80 + 32 + 8 * g + 4 * hie) = pk4_fp8(o[u][1][4 * g] * il, o[u][1][4 * g + 1] * il, o[u][1][4 * g + 2] * il, o[u][1][4 * g + 3] * il); }
            asm volatile("s_waitcnt lgkmcnt(0)" ::: "memory");
            unsigned char* dstw = (unsigned char*)AO + ((size_t)b * SEQ + qb2 * 512 + u * 256 + wave * 32) * D + h * 64;
#pragma unroll
            for (int i = 0; i < 2; ++i) { const int row = 16 * i + (lane_e >> 2), ch = lane_e & 3; *(u32x4*)(dstw + (size_t)row * D + ch * 16) = *(const LAS u32x4*)(ost + row * 80 + ch * 16); }
            asm volatile("s_waitcnt lgkmcnt(0)" ::: "memory");
#else
            const float il = 1.0f / l;
#pragma unroll
            for (int g = 0; g < 4; ++g) { u32x2 w0, w1; w0.x = cvtpk(o[u][0][4 * g] * il, o[u][0][4 * g + 1] * il); w0.y = cvtpk(o[u][0][4 * g + 2] * il, o[u][0][4 * g + 3] * il); w1.x = cvtpk(o[u][1][4 * g] * il, o[u][1][4 * g + 1] * il); w1.y = cvtpk(o[u][1][4 * g + 2] * il, o[u][1][4 * g + 3] * il);
                *(LAS u32x2*)(ost + r32e * 144 + (8 * g + 4 * hie) * 2) = w0; *(LAS u32x2*)(ost + r32e * 144 + (32 + 8 * g + 4 * hie) * 2) = w1; }
            asm volatile("s_waitcnt lgkmcnt(0)" ::: "memory");
            bf16* dstw = AO + ((size_t)b * SEQ + qb2 * 512 + u * 256 + wave * 32) * D + h * 64;
#pragma unroll
            for (int i = 0; i < 4; ++i) { const int row = 8 * i + (lane_e >> 3), ch = lane_e & 7; *(u32x4*)(dstw + (size_t)row * D + ch * 8) = *(const LAS u32x4*)(ost + row * 144 + ch * 16); }
            asm volatile("s_waitcnt lgkmcnt(0)" ::: "memory");
#endif
        }
    }
}

constexpr int NPHASE = 23;
template <int PH> __global__ void __launch_bounds__(NTHR, 2) fwd_kernel(Args args) {
    extern __shared__ __attribute__((aligned(16))) unsigned char lds_raw[];
    Frame F;
    F.lds = (LAS unsigned char*)lds_raw;
    volatile LAS unsigned* MISC = (volatile LAS unsigned*)(F.lds + MISC_OFF);
    if (threadIdx.x < 32) MISC[threadIdx.x] = 0u;
    __syncthreads();
    const int wv0_ = __builtin_amdgcn_readfirstlane((int)(threadIdx.x >> 6));
    const int lo = args.ph_lo, hi = args.ph_hi;
#if MK_N_LAUNCHES == 1
    XcdBarrier bar = xcd_barrier_post((unsigned*)(args.ws + WS_CTL) + CW_BAR, MISC + 8);
#define GRID_BAR() xcd_barrier(bar)
#else
#define GRID_BAR() do {} while (0)
#endif
#define IN(k) ((PH < 0 || (k) == PH) && lo <= (k) && (k) < hi)
#define SEAM(k) do { if (IN(k) && IN((k) + 1)) GRID_BAR(); } while (0)
#define FRESH() { int t_ = wv0_ * 64 + (int)__builtin_amdgcn_mbcnt_hi(~0u, __builtin_amdgcn_mbcnt_lo(~0u, 0u)); asm volatile("" : "+v"(t_)); KArgs kp_ = (KArgs)__builtin_amdgcn_kernarg_segment_ptr(); asm volatile("" : "+s"(kp_)); \
        F.tid = t_; F.lane = t_ & 63; F.wave = __builtin_amdgcn_readfirstlane(t_ >> 6); F.G = gridDim.x; F.gw = blockIdx.x * NWAVES + F.wave; F.ngw = F.G * NWAVES; F.a = kp_; F.ws = kp_->ws; } \
        unsigned char* ws = F.ws; float* const outp = F.a->out; const float* mod0 = (const float*)(ws + WS_MOD); const float* mod1 = mod0 + 33 * 6144; (void)outp; (void)mod0; (void)mod1;

    if (IN(0)) { FRESH(); phase_prologue(F);
#if defined(DUP_PHASE) && DUP_PHASE == 0
        __syncthreads(); phase_prologue(F);
#endif
    } SEAM(0);
    if (IN(1)) { FRESH(); phase_ew0(F); phase_router_tables(F); } SEAM(1);
    if (IN(2)) {
        FRESH();
        pg8::Gemm g{(const bf16*)(ws + WS_H), D, 0, nullptr, (const bf16*)(ws + WS_W1T), 0, D, D, 0}; pg8::DenseOrder S; S.init(T, 5120, F.G, (int)blockIdx.x);
        pg8::EpiHgIn E{(bf16*)(ws + WS_P), (const float*)(ws + WS_LB)};
        pg8::gemm_phase<pg8::EpiHgIn, pg8::DenseOrder, false>(F.lds, g, S, E, F.wave);
    } SEAM(2);
    if (IN(3)) { FRESH(); phase_gla(F);
#if defined(DUP_PHASE) && DUP_PHASE == 3
        __syncthreads(); phase_gla(F);
#endif
    } SEAM(3);
    if (IN(5)) {
        FRESH();
#if HG_FP8
        pg8::Gemm g{(const bf16*)((const unsigned char*)outp + A8_OFF), 512, 0, nullptr, (const bf16*)(ws + WS_W2T), 0, 512, 512, 0}; pg8::DenseOrder S; S.init(T, D, F.G, (int)blockIdx.x);
        pg8::EpiResid E{F.a->in[I_CTX], F.a->in[I_X], nullptr, (bf16*)(ws + WS_X1), mod0 + 2 * 1024, 0, 1.0f / 256.0f};
        pg8::gemm_phase<pg8::EpiResid, pg8::DenseOrder, false, true>(F.lds, g, S, E, F.wave);
#if MOE_FP8
        { const int nun = (T / 256) * 4, extra = nun - (nun / F.G) * F.G;
          if (extra > 0 && (int)blockIdx.x >= extra) { __syncthreads(); moe_convert8(F, 0, ws + WS_MOEW0, MOE0_SPLIT, 1 << 30, ((int)blockIdx.x - extra) * NWAVES + F.wave, (F.G - extra) * NWAVES); }
          else if (extra == 0) { __syncthreads(); moe_convert8(F, 0, ws + WS_MOEW0, MOE0_SPLIT, 1 << 30); } }
#endif
#else
        pg8::Gemm g{(const bf16*)outp, D, 0, nullptr, (const bf16*)(ws + WS_W2T), 0, D, D, 0}; pg8::DenseOrder S; S.init(T, D, F.G, (int)blockIdx.x);
        pg8::EpiResid E{F.a->in[I_CTX], F.a->in[I_X], nullptr, (bf16*)(ws + WS_X1), mod0 + 2 * 1024, 0, 1.0f};
        pg8::gemm_phase<pg8::EpiResid, pg8::DenseOrder, false>(F.lds, g, S, E, F.wave);
#endif
    } SEAM(5);
    const bool ew_router_fused = MOE_FP8 && (gridDim.x == 256);
    if (IN(6)) { FRESH(); phase_ew2(F, 0, (const bf16*)(ws + WS_X1), 0, 0, MOE_FP8 ? (unsigned char*)outp : nullptr);
        if (ew_router_fused) { asm volatile("s_waitcnt vmcnt(0)" ::: "memory"); __syncthreads(); phase_router(F, 0, 0, T / 256, (const bf16*)(ws + WS_X1), 0); } }
    if (!ew_router_fused) { SEAM(6); if (IN(7)) { FRESH(); phase_router(F, 0, 0, T / 256, (const bf16*)(ws + WS_X1), 0); } }
    do { if (IN(7) && IN(8)) GRID_BAR(); } while (0);
    if (IN(8)) { FRESH(); phase_assign(F, 0, T / 256); } SEAM(8);
    if (IN(9)) {
        FRESH();
        const int nblk = __builtin_amdgcn_readfirstlane(((const int*)(ws + WS_META))[0]);
#if MOE_FP8
        pg8::Gemm g{(const bf16*)outp, 512, 0, (const int*)(ws + WS_TOKROW), (const bf16*)(ws + WS_MOEW0), (size_t)1024 * 512, 512, 512, 0}; pg8::MoeOrder S; S.init((const int*)(ws + WS_BLKE), nblk, F.G, (int)blockIdx.x);
        pg8::EpiSwiGLU8 E{ws + WS_ACT};
        pg8::gemm_phase<pg8::EpiSwiGLU8, pg8::MoeOrder, true, true>(F.lds, g, S, E, F.wave);
#else
        pg8::Gemm g{(const bf16*)(ws + WS_H), D, 0, (const int*)(ws + WS_TOKROW), (const bf16*)(ws + WS_MOEW0), (size_t)1024 * 1024, D, D, 0}; pg8::MoeOrder S; S.init((const int*)(ws + WS_BLKE), nblk, F.G, (int)blockIdx.x);
        pg8::EpiSwiGLU E{(bf16*)(ws + WS_ACT)};
        pg8::gemm_phase<pg8::EpiSwiGLU, pg8::MoeOrder, true>(F.lds, g, S, E, F.wave);
#endif
    } SEAM(9);
    if (IN(10)) {
        FRESH();
        const int nblk = __builtin_amdgcn_readfirstlane(((const int*)(ws + WS_META))[0]);
#if MOE_FP8
        pg8::Gemm g{(const bf16*)(ws + WS_ACT), 256, 0, nullptr, (const bf16*)(ws + WS_MOEW0 + (size_t)NEXP * 1024 * 1024), (size_t)1024 * 256, 256, 256, 0}; pg8::MoeOrder S; S.init((const int*)(ws + WS_BLKE), nblk, F.G, (int)blockIdx.x);
        pg8::EpiDown8 E{(bf16*)(ws + WS_Y), (const float*)(ws + WS_WROW), F.lds + RING_BYTES + 4096};
        pg8::gemm_phase<pg8::EpiDown8, pg8::MoeOrder, false, true>(F.lds, g, S, E, F.wave);
#else
        pg8::Gemm g{(const bf16*)(ws + WS_ACT), FF, 0, nullptr, (const bf16*)(ws + WS_MOEW0) + (size_t)NEXP * 1024 * 1024, (size_t)1024 * 512, FF, FF, 0}; pg8::MoeOrder S; S.init((const int*)(ws + WS_BLKE), nblk, F.G, (int)blockIdx.x);
        pg8::EpiDown E{(bf16*)(ws + WS_Y), (const float*)(ws + WS_WROW)};
        pg8::gemm_phase<pg8::EpiDown, pg8::MoeOrder, false>(F.lds, g, S, E, F.wave);
#endif
    } SEAM(10);
    if (IN(11)) { FRESH(); phase_combine<false>(F, 0, (const bf16*)(ws + WS_X1), 0, 0, (const bf16*)(ws + WS_Y), (bf16*)(ws + WS_X2B), nullptr); } SEAM(11);
    if (IN(12)) {
        FRESH();
#if C_FP8
        pg8::Gemm g{(const bf16*)(ws + WS_H), 512, 0, nullptr, (const bf16*)(ws + WS_WMIN), 0, 512, 512, 0}; pg8::DenseOrder S; S.init(T, 512, F.G, (int)blockIdx.x);
#else
        pg8::Gemm g{(const bf16*)(ws + WS_H), D, 0, nullptr, (const bf16*)(ws + WS_WMIN), 0, D, D, 0}; pg8::DenseOrder S; S.init(T, 512, F.G, (int)blockIdx.x);
#endif
#if C_FP8
        pg8::EpiC E{(bf16*)(ws + WS_C), (float*)(ws + WS_SS4), (float*)(ws + WS_SSQ), ws + WS_C8};
        pg8::gemm_phase<pg8::EpiC, pg8::DenseOrder, false, true>(F.lds, g, S, E, F.wave);
#else
        pg8::EpiC E{(bf16*)(ws + WS_C), (float*)(ws + WS_SS4), (float*)(ws + WS_SSQ), ws + WS_C8};
        pg8::gemm_phase<pg8::EpiC, pg8::DenseOrder, false>(F.lds, g, S, E, F.wave);
#endif
#if MOE_FP8
        { const int nun = (T / 256) * 2, extra = nun - (nun / F.G) * F.G;
          if (extra > 0 && (int)blockIdx.x >= extra) { __syncthreads(); moe_convert8(F, 1, ws + WS_MOEW1, 0, MOE1_SPLIT, ((int)blockIdx.x - extra) * NWAVES + F.wave, (F.G - extra) * NWAVES); }
          else if (extra == 0) { __syncthreads(); moe_convert8(F, 1, ws + WS_MOEW1, 0, MOE1_SPLIT); } }
#endif
    } SEAM(12);
    if (IN(13)) {
        FRESH();
        { pg8::Gemm g{(const bf16*)(ws + WS_C), 512, 256, nullptr, (const bf16*)(ws + WS_WKVB), 0, 128, 128, 0}; pg8::DenseOrder S; S.init(T, 1024, F.G, (int)blockIdx.x);
          { LAS float* rl_ = (LAS float*)(F.lds + RING_BYTES); for (int i = F.tid; i < 1024; i += NTHR) rl_[i] = ((const float*)(ws + WS_ROPE))[i]; __syncthreads(); }
          pg8::EpiKf E{(bf16*)(ws + WS_KF), (const bf16*)(ws + WS_C), (const float*)(ws + WS_SS4), F.a->in[I_MKQK], (const LAS float*)(F.lds + RING_BYTES), F.lds + RING_BYTES + 4096};
          pg8::gemm_phase<pg8::EpiKf, pg8::DenseOrder, false>(F.lds, g, S, E, F.wave); }
        __syncthreads();
        { pg8::Gemm g{(const bf16*)(ws + WS_WKVB) + (size_t)1024 * 128, 128, 0, nullptr, (const bf16*)(ws + WS_C), 0, 128, 512, 256}; pg8::DenseOrder S; S.init(1024, T, F.G, ((int)blockIdx.x + F.G / 2) % F.G);
#if ATT_FP8
          pg8::EpiVt E{(bf16*)(ws + WS_VF), (const float*)(ws + WS_SS4), F.lds + RING_BYTES + 4096};
#else
          pg8::EpiVt E{(bf16*)(ws + WS_VF), (const float*)(ws + WS_SS4)};
#endif
          pg8::gemm_phase<pg8::EpiVt, pg8::DenseOrder, false>(F.lds, g, S, E, F.wave);
#if defined(DUP_PHASE) && DUP_PHASE == 13
          __syncthreads(); pg8::gemm_phase<pg8::EpiVt, pg8::DenseOrder, false>(F.lds, g, S, E, F.wave);
#endif
#if defined(DUP_PHASE) && DUP_PHASE == 113
          __syncthreads(); pg8::gemm_phase<pg8::EpiVt, pg8::DenseOrder, false>(F.lds, g, S, E, F.wave); __syncthreads(); pg8::gemm_phase<pg8::EpiVt, pg8::DenseOrder, false>(F.lds, g, S, E, F.wave);
#endif
        }
    } SEAM(13);
    if (IN(15)) { FRESH();
#if ATT_FP8 == 2
        phase_attn8x2(F);
#else
        phase_attn(F);
#endif
#if defined(DUP_PHASE) && DUP_PHASE == 15
        __syncthreads(); phase_attn(F);
#endif
    } SEAM(15);
    if (IN(16)) {
        FRESH();
#if AO_FP8
        pg8::Gemm g{(const bf16*)(ws + WS_AO), 512, 0, nullptr, (const bf16*)(ws + WS_W4T), 0, 512, 512, 0}; pg8::DenseOrder S; S.init(TL, D, F.G, (int)blockIdx.x);
        pg8::EpiResid E{nullptr, nullptr, (const bf16*)(ws + WS_X2B), (bf16*)(ws + WS_X2B), mod1 + 2 * 1024, 1, 1.0f / 512.0f};
        pg8::gemm_phase<pg8::EpiResid, pg8::DenseOrder, false, true>(F.lds, g, S, E, F.wave);
#else
        pg8::Gemm g{(const bf16*)(ws + WS_AO), D, 0, nullptr, (const bf16*)(ws + WS_W4T), 0, D, D, 0}; pg8::DenseOrder S; S.init(TL, D, F.G, (int)blockIdx.x);
        pg8::EpiResid E{nullptr, nullptr, (const bf16*)(ws + WS_X2B), (bf16*)(ws + WS_X2B), mod1 + 2 * 1024, 1, 1.0f};
        pg8::gemm_phase<pg8::EpiResid, pg8::DenseOrder, false>(F.lds, g, S, E, F.wave);
#endif
    } SEAM(16);
    if (IN(17)) { FRESH();
#if MOE_FP8
        phase_ew2(F, 1, (const bf16*)(ws + WS_X2B), TC, TC, ws + WS_AO - (size_t)TC * D);
        if (ew_router_fused) { asm volatile("s_waitcnt vmcnt(0)" ::: "memory"); __syncthreads(); phase_router(F, 1, TC, TL / 256, (const bf16*)(ws + WS_X2B), TC); __syncthreads(); }
        moe_convert8(F, 1, ws + WS_MOEW1, MOE1_SPLIT, 1 << 30);
#else
        phase_ew2(F, 1, (const bf16*)(ws + WS_X2B), TC, TC, nullptr); moe_convert(F, 1, (bf16*)(ws + WS_MOEW1));
#endif
    }
    if (!ew_router_fused) { SEAM(17); if (IN(18)) { FRESH(); phase_router(F, 1, TC, TL / 256, (const bf16*)(ws + WS_X2B), TC); } }
    do { if (IN(18) && IN(19)) GRID_BAR(); } while (0);
    if (IN(19)) { FRESH(); phase_assign(F, TC, TL / 256); } SEAM(19);
    if (IN(20)) {
        FRESH();
        const int nblk = __builtin_amdgcn_readfirstlane(((const int*)(ws + WS_META))[0]);
#if MOE_FP8
        pg8::Gemm g{(const bf16*)(ws + WS_AO - (size_t)TC * D), 512, 0, (const int*)(ws + WS_TOKROW), (const bf16*)(ws + WS_MOEW1), (size_t)1024 * 512, 512, 512, 0}; pg8::MoeOrder S; S.init((const int*)(ws + WS_BLKE), nblk, F.G, (int)blockIdx.x);
        pg8::EpiSwiGLU8 E{ws + WS_ACT1};
        pg8::gemm_phase<pg8::EpiSwiGLU8, pg8::MoeOrder, true, true>(F.lds, g, S, E, F.wave);
#else
        pg8::Gemm g{(const bf16*)(ws + WS_H), D, 0, (const int*)(ws + WS_TOKROW), (const bf16*)(ws + WS_MOEW1), (size_t)1024 * 1024, D, D, 0}; pg8::MoeOrder S; S.init((const int*)(ws + WS_BLKE), nblk, F.G, (int)blockIdx.x);
        pg8::EpiSwiGLU E{(bf16*)(ws + WS_ACT1)};
        pg8::gemm_phase<pg8::EpiSwiGLU, pg8::MoeOrder, true>(F.lds, g, S, E, F.wave);
#endif
    } SEAM(20);
    if (IN(21)) {
        FRESH();
        const int nblk = __builtin_amdgcn_readfirstlane(((const int*)(ws + WS_META))[0]);
#if MOE_FP8
        pg8::Gemm g{(const bf16*)(ws + WS_ACT1), 256, 0, nullptr, (const bf16*)(ws + WS_MOEW1 + (size_t)NEXP * 1024 * 1024), (size_t)1024 * 256, 256, 256, 0}; pg8::MoeOrder S; S.init((const int*)(ws + WS_BLKE), nblk, F.G, (int)blockIdx.x);
        pg8::EpiDown8 E{(bf16*)(ws + WS_Y1), (const float*)(ws + WS_WROW), F.lds + RING_BYTES + 4096};
        pg8::gemm_phase<pg8::EpiDown8, pg8::MoeOrder, false, true>(F.lds, g, S, E, F.wave);
#else
        pg8::Gemm g{(const bf16*)(ws + WS_ACT1), FF, 0, nullptr, (const bf16*)(ws + WS_MOEW1) + (size_t)NEXP * 1024 * 1024, (size_t)1024 * 512, FF, FF, 0}; pg8::MoeOrder S; S.init((const int*)(ws + WS_BLKE), nblk, F.G, (int)blockIdx.x);
        pg8::EpiDown E{(bf16*)(ws + WS_Y1), (const float*)(ws + WS_WROW)};
        pg8::gemm_phase<pg8::EpiDown, pg8::MoeOrder, false>(F.lds, g, S, E, F.wave);
#endif
    } SEAM(21);
    if (IN(22)) { FRESH(); phase_combine<true>(F, 1, (const bf16*)(ws + WS_X2B), TC, TC, (const bf16*)(ws + WS_Y1), nullptr, outp); }
#undef IN
#undef SEAM
#undef FRESH
}

template <int PH> static bool setup_one() { return hipFuncSetAttribute((const void*)fwd_kernel<PH>, hipFuncAttributeMaxDynamicSharedMemorySize, LDS_BYTES) == hipSuccess; }
template <int PH> static void launch_one(int grid, hipStream_t stream, Args a) { a.ph_lo = PH; a.ph_hi = PH + 1; hipLaunchKernelGGL(fwd_kernel<PH>, dim3(grid), dim3(NTHR), LDS_BYTES, stream, a); }
extern "C" void kernel_launch(void* const* d_in, const int* in_sizes, int n_in, void* d_out, int out_size, void* d_ws, size_t ws_size, hipStream_t stream) {
    static int grid = 0;
    if (grid == 0) {
        if (n_in != 25 || out_size != TL * D || ws_size < WS_END) { fprintf(stderr, "kernel_launch: unexpected shapes (n_in %d out %d ws %zu)\n", n_in, out_size, ws_size); grid = -1; return; }
        int dev = 0, cus = 0;
        if (hipGetDevice(&dev) != hipSuccess || hipDeviceGetAttribute(&cus, hipDeviceAttributeMultiprocessorCount, dev) != hipSuccess) { grid = -1; return; }
        bool ok = true;
#if MK_N_LAUNCHES == 1
        ok = setup_one<-1>();
#else
        ok = ok && setup_one<0>() && setup_one<1>() && setup_one<2>() && setup_one<3>() && setup_one<4>() && setup_one<5>() && setup_one<6>() && setup_one<7>() && setup_one<8>() && setup_one<9>() && setup_one<10>() && setup_one<11>();
        ok = ok && setup_one<12>() && setup_one<13>() && setup_one<14>() && setup_one<15>() && setup_one<16>() && setup_one<17>() && setup_one<18>() && setup_one<19>() && setup_one<20>() && setup_one<21>() && setup_one<22>();
#endif
        if (!ok) { fprintf(stderr, "kernel_launch: hipFuncSetAttribute failed\n"); grid = -1; return; }
        (void)hipGetLastError();
        grid = cus;
        if (grid != 256) fprintf(stderr, "kernel_launch: %d CUs (built for 256)\n", grid);
    }
    if (grid < 0) return;
    (void)hipMemsetAsync((char*)d_ws + WS_CTL, 0, CTL_ZERO_BYTES, stream);
    Args a{};
    for (int i = 0; i < 25; ++i) a.in[i] = (const float*)d_in[i];
    a.out = (float*)d_out; a.ws = (unsigned char*)d_ws;
#if MK_N_LAUNCHES == 1
    a.ph_lo = 0; a.ph_hi = NPHASE;
    hipLaunchKernelGGL(fwd_kernel<-1>, dim3(grid), dim3(NTHR), LDS_BYTES, stream, a);
#else
    launch_one<0>(grid, stream, a); launch_one<1>(grid, stream, a); launch_one<2>(grid, stream, a); launch_one<3>(grid, stream, a); launch_one<4>(grid, stream, a); launch_one<5>(grid, stream, a);
    launch_one<6>(grid, stream, a); launch_one<7>(grid, stream, a); launch_one<8>(grid, stream, a); launch_one<9>(grid, stream, a); launch_one<10>(grid, stream, a); launch_one<11>(grid, stream, a);
    launch_one<12>(grid, stream, a); launch_one<13>(grid, stream, a); launch_one<14>(grid, stream, a); launch_one<15>(grid, stream, a); launch_one<16>(grid, stream, a); launch_one<17>(grid, stream, a);
    launch_one<18>(grid, stream, a); launch_one<19>(grid, stream, a); launch_one<20>(grid, stream, a); launch_one<21>(grid, stream, a); launch_one<22>(grid, stream, a);
#endif
}
```
